# Optimizing an MI355X kernel written in HIP

```python
import math
import jax, jax.numpy as jnp
from jax import lax
import numpy as np

D_MODEL = 2048
BATCH = 4
SEQ = 2048
DEPTH = 2
DEC_BATCH = 32
DEC_SEQ = 8
PAST_LEN = 8192
PAGE_SIZE = 128

N_EVEN = (DEPTH + 1) // 2
N_ODD = DEPTH // 2
HEAD_DIM = D_MODEL // 16
RET_HEADS = 8
RET_DK = HEAD_DIM
RET_DV = 2 * HEAD_DIM
SWA_GROUPS = ((128, 1), (512, 4), (2048, 16))
N_SWA_GROUPS = 3
SWA_HEADS = 8
SWA_DH = HEAD_DIM
N_REL_BUCKETS = 32
REL_MAX_DIST = 2048
GDN_QK_HEADS = 16
GDN_V_HEADS = 32
GDN_DK = HEAD_DIM
GDN_DV = HEAD_DIM
CONV_W = 4
MEM_TOKENS = 256
MEM_HEADS = 4
MEM_DH = HEAD_DIM
D_FF = 4 * D_MODEL
CHUNK = 64
Q_BLOCK = 128
EPS = 1e-6
ROPE_BASE = 10000.0

RET_QW = RET_HEADS * RET_DK
RET_VW = RET_HEADS * RET_DV
SWA_W = N_SWA_GROUPS * SWA_HEADS * SWA_DH
EVEN_IN = 2 * RET_QW + 2 * RET_VW + 3 * SWA_W
EVEN_SPLITS = (RET_QW, 2 * RET_QW, 2 * RET_QW + RET_VW, 2 * RET_QW + 2 * RET_VW,
               2 * RET_QW + 2 * RET_VW + SWA_W, 2 * RET_QW + 2 * RET_VW + 2 * SWA_W)
EVEN_OUT = RET_VW + SWA_HEADS * SWA_DH
GDN_QW = GDN_QK_HEADS * GDN_DK
GDN_VW = GDN_V_HEADS * GDN_DV
GDN_CONV_CH = 2 * GDN_QW + GDN_VW
ODD_IN = GDN_CONV_CH + GDN_VW + 2 * GDN_V_HEADS
ODD_SPLITS = (GDN_CONV_CH, GDN_CONV_CH + GDN_VW, GDN_CONV_CH + GDN_VW + GDN_V_HEADS)
MEM_W = MEM_HEADS * MEM_DH

kernel_name = 'hybrid_retention_dilated_gdn_decoder_step'


def _rmsnorm(x, g):
    xf = x.astype(jnp.float32)
    y = xf * lax.rsqrt(jnp.mean(xf * xf, axis=-1, keepdims=True) + EPS)
    return (y * g.astype(jnp.float32)).astype(x.dtype)


def _l2norm(x):
    xf = x.astype(jnp.float32)
    return xf * lax.rsqrt(jnp.sum(xf * xf, axis=-1, keepdims=True) + EPS)


def _chunk_len(t):
    return CHUNK if t % CHUNK == 0 else t


def _rotary(x, pos):
    half = x.shape[-1] // 2
    inv = ROPE_BASE ** (-jnp.arange(half, dtype=jnp.float32) / half)
    ang = pos.astype(jnp.float32)[:, None] * inv[None, :]
    cos = jnp.cos(ang)[None, :, None, :]
    sin = jnp.sin(ang)[None, :, None, :]
    xf = x.astype(jnp.float32)
    x1, x2 = xf[..., :half], xf[..., half:]
    return jnp.concatenate([x1 * cos - x2 * sin, x1 * sin + x2 * cos], axis=-1)


def _t5_bucket(dist):
    exact = N_REL_BUCKETS // 2
    d = jnp.maximum(dist.astype(jnp.float32), 1.0)
    large = exact + (jnp.log(d / exact) / math.log(REL_MAX_DIST / exact)
                     * (N_REL_BUCKETS - exact)).astype(jnp.int32)
    large = jnp.minimum(large, N_REL_BUCKETS - 1)
    return jnp.where(dist < exact, dist, large)


def _retention(q, k, v, s0):
    b, t, h, dk = q.shape
    dv = v.shape[-1]
    c = _chunk_len(t)
    n = t // c
    log_gamma = jnp.log1p(-jnp.exp2(-5.0 - jnp.arange(h, dtype=jnp.float32)))
    idx = jnp.arange(c, dtype=jnp.float32)
    diff = idx[:, None] - idx[None, :]
    intra_decay = jnp.where(diff >= 0, jnp.exp(jnp.maximum(diff, 0.0)[None] * log_gamma[:, None, None]), 0.0)
    from_start = jnp.exp((idx[:, None] + 1.0) * log_gamma[None, :])
    to_end = jnp.exp((c - 1.0 - idx)[:, None] * log_gamma[None, :])
    chunk_decay = jnp.exp(c * log_gamma)
    qc = (q * dk ** -0.5).reshape(b, n, c, h, dk)
    kc = k.reshape(b, n, c, h, dk)
    vc = v.astype(jnp.float32).reshape(b, n, c, h, dv)
    scores = jnp.einsum('bnqhd,bnkhd->bnhqk', qc, kc) * intra_decay[None, None]
    intra = jnp.einsum('bnhqk,bnkhe->bnqhe', scores, vc)
    chunk_kv = jnp.einsum('bnkhd,kh,bnkhe->nbhde', kc, to_end, vc)

    def step(s, kv):
        return chunk_decay[None, :, None, None] * s + kv, s

    s_fin, s_in = lax.scan(step, s0.astype(jnp.float32), chunk_kv)
    inter = jnp.einsum('bnqhd,nbhde->bnqhe', qc, s_in) * from_start[None, None, :, :, None]
    return (intra + inter).reshape(b, t, h, dv), s_fin


def _head_groupnorm(y, g):
    mu = jnp.mean(y, axis=-1, keepdims=True)
    var = jnp.mean(jnp.square(y - mu), axis=-1, keepdims=True)
    return (y - mu) * lax.rsqrt(var + EPS) * g.astype(jnp.float32)


def _dilated_group(q, k_all, v_all, q_start, k_start, window, dilation, bias_tab):
    b, tq, h, dh = q.shape
    tk = k_all.shape[1]
    n_keys = window // dilation + 1
    qb = Q_BLOCK if tq % Q_BLOCK == 0 else tq
    dist = jnp.arange(n_keys, dtype=jnp.int32) * dilation
    rel = bias_tab[_t5_bucket(dist)].astype(jnp.float32).T

    def block(i):
        q_blk = lax.dynamic_slice_in_dim(q, i * qb, qb, axis=1)
        q_pos = q_start + i * qb + jnp.arange(qb, dtype=jnp.int32)
        k_idx = q_pos[:, None] - dist[None, :] - k_start
        valid = k_idx >= 0
        k_idx = jnp.clip(k_idx, 0, tk - 1)
        k_g = k_all[:, k_idx]
        v_g = v_all[:, k_idx]
        s = jnp.einsum('bqhd,bqkhd->bhqk', q_blk, k_g).astype(jnp.float32) * dh ** -0.5 + rel[None, :, None, :]
        s = jnp.where(valid[None, None], s, -jnp.inf)
        m = jnp.max(s, axis=-1, keepdims=True)
        p = jnp.exp(s - m)
        den = jnp.sum(p, axis=-1, keepdims=True)
        o = jnp.einsum('bhqk,bqkhd->bqhd', p / den, v_g.astype(jnp.float32))
        lse = (m + jnp.log(den))[..., 0]
        return o, lse

    o, lse = lax.map(block, jnp.arange(tq // qb))
    o = jnp.moveaxis(o, 0, 1).reshape(b, tq, h, dh)
    lse = jnp.transpose(lse, (1, 0, 3, 2)).reshape(b, tq, h)
    return o, lse


def _even_mixer(u, t0, ret_state, swa_bufs, w_in, gn_w, q_norm, k_norm, rel_bias, w_out):
    b, t, _ = u.shape
    proj = jnp.einsum('btd,de->bte', u, w_in)
    q_r, k_r, v_r, g_r, q_s, k_s, v_s = jnp.split(proj, EVEN_SPLITS, axis=-1)
    pos = t0 + jnp.arange(t, dtype=jnp.int32)
    q_r = _rotary(q_r.reshape(b, t, RET_HEADS, RET_DK), pos)
    k_r = _rotary(k_r.reshape(b, t, RET_HEADS, RET_DK), pos)
    v_r = v_r.reshape(b, t, RET_HEADS, RET_DV)
    if ret_state is None:
        ret_state = jnp.zeros((b, RET_HEADS, RET_DK, RET_DV), jnp.float32)
    y_r, s_new = _retention(q_r, k_r, v_r, ret_state)
    y_r = _head_groupnorm(y_r, gn_w).reshape(b, t, RET_VW) * jax.nn.silu(g_r.astype(jnp.float32))

    shp = (b, t, N_SWA_GROUPS, SWA_HEADS, SWA_DH)
    q_s = _rmsnorm(q_s.reshape(shp), q_norm)
    k_s = _rmsnorm(k_s.reshape(shp), k_norm)
    v_s = v_s.reshape(shp)
    outs, lses, rows = [], [], []
    for gi, (win, dil) in enumerate(SWA_GROUPS):
        qg, kg, vg = q_s[:, :, gi], k_s[:, :, gi], v_s[:, :, gi]
        bias_g = rel_bias[:, gi * SWA_HEADS:(gi + 1) * SWA_HEADS]
        if swa_bufs is None:
            k_all, v_all, k_start = kg, vg, t0
            keep = min(win, t)
            rows.append(jnp.stack([kg[:, t - keep:], vg[:, t - keep:]], axis=2))
        else:
            buf = swa_bufs[gi]
            k_all = jnp.concatenate([buf[:, :, 0].astype(kg.dtype), kg], axis=1)
            v_all = jnp.concatenate([buf[:, :, 1].astype(vg.dtype), vg], axis=1)
            k_start = t0 - buf.shape[1]
            rows.append(jnp.stack([kg, vg], axis=2))
        o, lse = _dilated_group(qg, k_all, v_all, t0, k_start, win, dil, bias_g)
        outs.append(o)
        lses.append(lse)
    wts = jax.nn.softmax(jnp.stack(lses), axis=0)
    y_s = jnp.einsum('gbth,gbthd->bthd', wts, jnp.stack(outs)).reshape(b, t, SWA_HEADS * SWA_DH)
    y = jnp.concatenate([y_r, y_s], axis=-1).astype(u.dtype)
    return jnp.einsum('bte,ed->btd', y, w_out), s_new, rows


def _gated_delta(q, k, v, g, beta, s0):
    b, t, h, dk = q.shape
    dv = v.shape[-1]
    c = _chunk_len(t)
    n = t // c

    def chunks(x):
        x = x.reshape((b, n, c, h) + x.shape[3:])
        return jnp.moveaxis(x, (1, 3), (0, 2))

    qc = chunks(q * dk ** -0.5)
    kc = chunks(k)
    vc = chunks(v.astype(jnp.float32))
    gc = jnp.cumsum(chunks(g), axis=-1)
    bc = chunks(beta)
    causal = jnp.tril(jnp.ones((c, c), dtype=bool))
    strict = jnp.tril(jnp.ones((c, c), dtype=bool), -1)
    decay = jnp.exp(jnp.where(causal, gc[..., :, None] - gc[..., None, :], -jnp.inf))
    kb = kc * bc[..., None]
    vb = vc * bc[..., None]
    m = jnp.where(strict, jnp.einsum('nbhcd,nbhsd->nbhcs', kb, kc) * decay, 0.0)
    a = jnp.eye(c, dtype=jnp.float32) + m
    u_c = lax.linalg.triangular_solve(a, vb, left_side=True, lower=True, unit_diagonal=True)
    w_c = lax.linalg.triangular_solve(a, kb * jnp.exp(gc)[..., None], left_side=True, lower=True, unit_diagonal=True)
    attn = jnp.einsum('nbhcd,nbhsd->nbhcs', qc, kc) * decay

    def step(s, xs):
        q_n, k_n, u_n, w_n, g_n, attn_n = xs
        v_new = u_n - jnp.einsum('bhcd,bhde->bhce', w_n, s)
        o = (jnp.einsum('bhcd,bhde->bhce', q_n * jnp.exp(g_n)[..., None], s)
             + jnp.einsum('bhcs,bhse->bhce', attn_n, v_new))
        g_last = g_n[..., -1:]
        s = (s * jnp.exp(g_last)[..., None]
             + jnp.einsum('bhcd,bhce->bhde', k_n * jnp.exp(g_last - g_n)[..., None], v_new))
        return s, o

    s_fin, o = lax.scan(step, s0.astype(jnp.float32), (qc, kc, u_c, w_c, gc, attn))
    o = jnp.moveaxis(o, (0, 2), (1, 3)).reshape(b, t, h, dv)
    return o, s_fin


def _gdn_mixer(u, conv_state, s0, w_in, conv_w, a_log, dt_bias, norm_w, w_out):
    b, t, _ = u.shape
    proj = jnp.einsum('btd,de->bte', u, w_in)
    qkv, z, beta_in, a_in = jnp.split(proj, ODD_SPLITS, axis=-1)
    if conv_state is None:
        conv_state = jnp.zeros((b, CONV_W - 1, GDN_CONV_CH), qkv.dtype)
    xpad = jnp.concatenate([conv_state.astype(qkv.dtype), qkv], axis=1)
    conv = xpad[:, 0:t] * conv_w[0]
    for j in range(1, CONV_W):
        conv = conv + xpad[:, j:j + t] * conv_w[j]
    conv = jax.nn.silu(conv.astype(jnp.float32))
    q, k, v = jnp.split(conv, (GDN_QW, 2 * GDN_QW), axis=-1)
    rep = GDN_V_HEADS // GDN_QK_HEADS
    q = jnp.repeat(_l2norm(q.reshape(b, t, GDN_QK_HEADS, GDN_DK)), rep, axis=2)
    k = jnp.repeat(_l2norm(k.reshape(b, t, GDN_QK_HEADS, GDN_DK)), rep, axis=2)
    v = v.reshape(b, t, GDN_V_HEADS, GDN_DV)
    beta = jax.nn.sigmoid(beta_in.astype(jnp.float32))
    g = -jnp.exp(a_log.astype(jnp.float32)) * jax.nn.softplus(a_in.astype(jnp.float32) + dt_bias.astype(jnp.float32))
    if s0 is None:
        s0 = jnp.zeros((b, GDN_V_HEADS, GDN_DK, GDN_DV), jnp.float32)
    y, s_fin = _gated_delta(q, k, v, g, beta, s0)
    y = _rmsnorm(y, norm_w) * jax.nn.silu(z.reshape(b, t, GDN_V_HEADS, GDN_DV).astype(jnp.float32))
    out = jnp.einsum('bte,ed->btd', y.reshape(b, t, GDN_VW).astype(u.dtype), w_out)
    return out, s_fin, xpad[:, -(CONV_W - 1):]


def _memory_kv(mem, g_src, w_kv, k_norm):
    b, m, _ = mem.shape
    kv = jnp.einsum('bmd,de->bme', _rmsnorm(mem, g_src), w_kv).reshape(b, m, 2, MEM_HEADS, MEM_DH)
    return jnp.stack([_rmsnorm(kv[:, :, 0], k_norm), kv[:, :, 1]], axis=2)


def _memory_attend(u, kv, w_q, q_norm, w_o):
    b, t, _ = u.shape
    q = _rmsnorm(jnp.einsum('btd,de->bte', u, w_q).reshape(b, t, MEM_HEADS, MEM_DH), q_norm)
    s = jnp.einsum('bthd,bmhd->bhtm', q, kv[:, :, 0].astype(q.dtype)).astype(jnp.float32) * MEM_DH ** -0.5
    p = jax.nn.softmax(s, axis=-1)
    o = jnp.einsum('bhtm,bmhd->bthd', p, kv[:, :, 1].astype(jnp.float32))
    return jnp.einsum('bte,ed->btd', o.reshape(b, t, MEM_W).astype(u.dtype), w_o)


def _sqrelu_mlp(u, w1, w2):
    hdn = jnp.square(jax.nn.relu(jnp.einsum('btd,df->btf', u, w1)))
    return jnp.einsum('btf,fd->btd', hdn, w2)


def setup_inputs(seed: int = 0) -> dict:
    key = jax.random.key(seed)
    ks = iter(jax.random.split(key, 48))

    def nrm(shape, scale):
        return jax.random.normal(next(ks), shape, jnp.float32) * scale

    def gain(shape):
        return 1.0 + 0.05 * jax.random.normal(next(ks), shape, jnp.float32)

    d = D_MODEL
    inp = {}
    inp['x_prompt'] = nrm((BATCH, SEQ, d), 1.0)
    inp['x_sample'] = nrm((DEC_BATCH, DEC_SEQ, d), 1.0)
    inp['mem_prompt'] = nrm((BATCH, MEM_TOKENS, d), 1.0)
    inp['state_ret'] = nrm((N_EVEN, DEC_BATCH, RET_HEADS, RET_DK, RET_DV), 0.05)
    inp['cache_swa1'] = nrm((N_EVEN, DEC_BATCH, min(SWA_GROUPS[0][0], PAST_LEN), 2, SWA_HEADS, SWA_DH), 1.0)
    inp['cache_swa2'] = nrm((N_EVEN, DEC_BATCH, min(SWA_GROUPS[1][0], PAST_LEN), 2, SWA_HEADS, SWA_DH), 1.0)
    inp['cache_swa3'] = nrm((N_EVEN, DEC_BATCH, min(SWA_GROUPS[2][0], PAST_LEN), 2, SWA_HEADS, SWA_DH), 1.0)
    inp['state_gdn'] = nrm((N_ODD, DEC_BATCH, GDN_V_HEADS, GDN_DK, GDN_DV), 0.05)
    inp['state_conv'] = nrm((N_ODD, DEC_BATCH, CONV_W - 1, GDN_CONV_CH), 1.0)
    inp['cache_mem'] = nrm((DEPTH, DEC_BATCH, MEM_TOKENS, 2, MEM_HEADS, MEM_DH), 1.0)
    inp['norm_mix'] = gain((DEPTH, d))
    inp['norm_mem'] = gain((DEPTH, d))
    inp['norm_memsrc'] = gain((DEPTH, d))
    inp['norm_ffn'] = gain((DEPTH, d))
    inp['w_in_even'] = nrm((N_EVEN, d, EVEN_IN), d ** -0.5)
    inp['ret_gn_w'] = gain((N_EVEN, RET_HEADS, RET_DV))
    inp['swa_qnorm'] = gain((N_EVEN, SWA_DH))
    inp['swa_knorm'] = gain((N_EVEN, SWA_DH))
    inp['rel_bias'] = nrm((N_REL_BUCKETS, N_SWA_GROUPS * SWA_HEADS), 0.5)
    inp['w_out_even'] = nrm((N_EVEN, EVEN_OUT, d), EVEN_OUT ** -0.5)
    inp['w_in_odd'] = nrm((N_ODD, d, ODD_IN), d ** -0.5)
    inp['gdn_conv_w'] = nrm((N_ODD, CONV_W, GDN_CONV_CH), CONV_W ** -0.5)
    inp['gdn_a_log'] = jnp.log(jax.random.uniform(next(ks), (N_ODD, GDN_V_HEADS), jnp.float32, 1.0, 16.0))
    dt = jnp.exp(jax.random.uniform(next(ks), (N_ODD, GDN_V_HEADS), jnp.float32, math.log(1e-3), math.log(1e-1)))
    inp['gdn_dt_bias'] = dt + jnp.log(-jnp.expm1(-dt))
    inp['gdn_norm_w'] = gain((N_ODD, GDN_DV))
    inp['w_out_odd'] = nrm((N_ODD, GDN_VW, d), GDN_VW ** -0.5)
    inp['mem_wq'] = nrm((DEPTH, d, MEM_W), d ** -0.5)
    inp['mem_wkv'] = nrm((DEPTH, d, 2 * MEM_W), d ** -0.5)
    inp['mem_qnorm'] = gain((DEPTH, MEM_DH))
    inp['mem_knorm'] = gain((DEPTH, MEM_DH))
    inp['mem_wo'] = nrm((DEPTH, MEM_W, d), MEM_W ** -0.5)
    inp['ffn_w1'] = nrm((DEPTH, d, D_FF), d ** -0.5)
    inp['ffn_w2'] = nrm((DEPTH, D_FF, d), D_FF ** -0.5)
    return inp


def reference(x_prompt, x_sample, mem_prompt, state_ret, cache_swa1, cache_swa2, cache_swa3,
              state_gdn, state_conv, cache_mem, norm_mix, norm_mem, norm_memsrc, norm_ffn,
              w_in_even, ret_gn_w, swa_qnorm, swa_knorm, rel_bias, w_out_even, w_in_odd,
              gdn_conv_w, gdn_a_log, gdn_dt_bias, gdn_norm_w, w_out_odd, mem_wq, mem_wkv,
              mem_qnorm, mem_knorm, mem_wo, ffn_w1, ffn_w2):

    def trunk(x, t0, mem, ret_in, swa_in, gdn_in, conv_in, mem_in):
        sample = ret_in is not None
        h = x
        ret_out, gdn_out, conv_out, mem_out = [], [], [], []
        swa_out = [[] for _ in SWA_GROUPS]
        for li in range(DEPTH):
            j = li // 2
            u = _rmsnorm(h, norm_mix[li])
            if li % 2 == 0:
                bufs = tuple(c[j] for c in swa_in) if sample else None
                mix, s_new, rows = _even_mixer(u, t0, ret_in[j] if sample else None, bufs, w_in_even[j],
                                               ret_gn_w[j], swa_qnorm[j], swa_knorm[j], rel_bias, w_out_even[j])
                ret_out.append(s_new)
                for gi in range(N_SWA_GROUPS):
                    swa_out[gi].append(rows[gi])
            else:
                mix, s_new, conv_new = _gdn_mixer(u, conv_in[j] if sample else None, gdn_in[j] if sample else None,
                                                  w_in_odd[j], gdn_conv_w[j], gdn_a_log[j], gdn_dt_bias[j],
                                                  gdn_norm_w[j], w_out_odd[j])
                gdn_out.append(s_new)
                conv_out.append(conv_new)
            h = h + mix
            if sample:
                kv = mem_in[li]
            else:
                kv = _memory_kv(mem, norm_memsrc[li], mem_wkv[li], mem_knorm[li])
                mem_out.append(kv)
            h = h + _memory_attend(_rmsnorm(h, norm_mem[li]), kv, mem_wq[li], mem_qnorm[li], mem_wo[li])
            h = h + _sqrelu_mlp(_rmsnorm(h, norm_ffn[li]), ffn_w1[li], ffn_w2[li])
        swa_stacked = [jnp.stack(s) for s in swa_out]
        return h, jnp.stack(ret_out), swa_stacked, jnp.stack(gdn_out), jnp.stack(conv_out), mem_out

    y_p, ret_p, swa_p, gdn_p, conv_p, mem_list = trunk(x_prompt, 0, mem_prompt, None, None, None, None, None)
    y_s, ret_s, swa_s, gdn_s, conv_s, _ = trunk(x_sample, PAST_LEN, None, state_ret,
                                                (cache_swa1, cache_swa2, cache_swa3),
                                                state_gdn, state_conv, cache_mem)
    mem_p = jnp.stack(mem_list)
    return (y_p, y_s, ret_p, ret_s, swa_p[0], swa_s[0], swa_p[1], swa_s[1], swa_p[2], swa_s[2],
            gdn_p, gdn_s, conv_p, conv_s, mem_p)
```

```cpp
#include <hip/hip_runtime.h>
#include <cstdio>
#include <cstdint>
namespace pg8 {
#define PG8_LAS __attribute__((address_space(3)))
typedef unsigned short bf16_t;
typedef short bf16x8 __attribute__((ext_vector_type(8)));
typedef float f32x4 __attribute__((ext_vector_type(4)));
typedef unsigned u32x4 __attribute__((ext_vector_type(4)));
constexpr int BM = 256, BK = 64, HALF = 128, HTB = HALF * BK * 2  , STAGE_BYTES = 8 * HTB, NXCD = 8, WGM = 8;

__host__ __device__ __forceinline__ int lds_byte(int r, int c) { const int st = (r >> 4) * 2 + (c >> 5), rr = r & 15, cc = c & 31, ob = rr * 64 + cc * 2; return st * 1024 + (ob ^ (((ob >> 9) & 1) << 5)); }
__host__ __device__ __forceinline__ void stage_rc(int b, int& R, int& C) { const int st = b / 1024, sb = b % 1024, swz = sb ^ (((sb >> 9) & 1) << 5); R = (st >> 1) * 16 + swz / 64; C = (st & 1) * 32 + (swz % 64) / 2; }
__host__ __device__ __forceinline__ int perm32(int rho) { const int n = rho >> 4, i = rho & 15; return 8 * (i >> 2) + 4 * n + (i & 3); }

struct Unit { int pm, pn; };
struct Gemm { const bf16_t* A; const bf16_t* Bt; int M, N, K; };

struct StaticOrder {
    int nM, nN, nwg, G, c;
    __host__ __device__ void init(int M, int N, int G_, int c_) { nM = M / BM; nN = N / BM; nwg = nM * nN; G = G_; c = c_; }
    __host__ __device__ bool next(int i, Unit& u) const {
        const long L = (long)i * G + c; if (L >= nwg) return false;
        int wgid = (int)L; { const int q = nwg / NXCD, r = nwg % NXCD, xcd = wgid % NXCD, off = wgid / NXCD; wgid = (xcd < r ? xcd * (q + 1) : r * (q + 1) + (xcd - r) * q) + off; }
        const int nig = WGM * nN, gid = wgid / nig, fm = gid * WGM, gsz = (nM - fm) < WGM ? (nM - fm) : WGM;
        u.pm = fm + ((wgid % nig) % gsz); u.pn = (wgid % nig) / gsz; return true;
    }
    __device__ __forceinline__ void a_ready(const Unit&) const {}
    __device__ __forceinline__ void done(const Unit&) const {}
};

__device__ __forceinline__ unsigned cvt_pk_bf16(float lo, float hi) { unsigned r; asm volatile("v_cvt_pk_bf16_f32 %0, %1, %2" : "=v"(r) : "v"(lo), "v"(hi)); return r; }
template <int ACT> struct EpiBf16 {
    static constexpr bool PERM = true, AFTER_DRAIN = false;
    bf16_t* O; int ldc;
    __device__ __forceinline__ void operator()(const f32x4 (&acc)[2][2][4][2], const Unit& u, int wr, int wc, int fr, int fq) const {
        const int row0 = u.pm * BM + wr * 64 + fr; const int col0 = u.pn * BM + wc * 32 + 8 * fq;
#pragma unroll
        for (int ai = 0; ai < 2; ++ai)
#pragma unroll
            for (int m = 0; m < 4; ++m) { bf16_t* rowp = O + (size_t)(row0 + ai * HALF + m * 16) * ldc + col0;
#pragma unroll
                for (int bj = 0; bj < 2; ++bj) { f32x4 v0 = acc[ai][bj][m][0], v1 = acc[ai][bj][m][1];
                    if (ACT == 2) {
#pragma unroll
                        for (int j = 0; j < 4; ++j) { const float a = fmaxf(v0[j], 0.f), b = fmaxf(v1[j], 0.f); v0[j] = a * a; v1[j] = b * b; } }
                    u32x4 w; w.x = cvt_pk_bf16(v0[0], v0[1]); w.y = cvt_pk_bf16(v0[2], v0[3]); w.z = cvt_pk_bf16(v1[0], v1[1]); w.w = cvt_pk_bf16(v1[2], v1[3]);
                    *(u32x4*)(rowp + bj * HALF) = w; } }
    }
};
struct EpiF32 {
    static constexpr bool PERM = false, AFTER_DRAIN = false;
    const float* base; float* C; int ldc;
    __device__ __forceinline__ void operator()(const f32x4 (&acc)[2][2][4][2], const Unit& u, int wr, int wc, int fr, int fq) const {
        const int row0 = u.pm * BM + wr * 64 + fr, col0 = u.pn * BM + wc * 32 + 4 * fq;
#pragma unroll
        for (int ai = 0; ai < 2; ++ai)
#pragma unroll
            for (int m = 0; m < 4; ++m) { const size_t off = (size_t)(row0 + ai * HALF + m * 16) * ldc + col0;
#pragma unroll
                for (int bj = 0; bj < 2; ++bj)
#pragma unroll
                    for (int n = 0; n < 2; ++n) { f32x4 v = acc[ai][bj][m][n]; if (base) v += *(const f32x4*)(base + off + bj * HALF + n * 16); *(f32x4*)(C + off + bj * HALF + n * 16) = v; } }
    }
};
template <class Epi, class Sched, bool ALIGN_EPI = false, bool SP2 = false>
__device__ __forceinline__ void gemm_phase(PG8_LAS unsigned char* lds, const Gemm g, const Sched& S, const Epi& E) {
    const int tid = threadIdx.x, wid = __builtin_amdgcn_readfirstlane(tid >> 6), lane = tid & 63, wr = wid >> 2, wc = wid & 3, fr = lane & 15, fq = lane >> 4;
    const int K = g.K, nt = K / BK;
    unsigned voffA[2], voffB[2];
#pragma unroll
    for (int i = 0; i < 2; ++i) { int R, C; stage_rc(tid * 16 + i * 8192, R, C); const int Rb = Epi::PERM ? ((R & ~31) + perm32(R & 31)) : R;
        voffA[i] = (unsigned)(R * K + C) * 2u; voffB[i] = (unsigned)(Rb * K + C) * 2u; }
    const size_t kstep = (size_t)(BK * 2);
    const size_t hstep = (size_t)HALF * K * 2;
    const size_t tstep = 2 * hstep;
    const unsigned ldsw = (unsigned)wid * 1024u;
    const int aoff = lds_byte(wr * 64 + fr, fq * 8), boff = lds_byte(wc * 32 + fr, fq * 8);
#define PG8_SA(b, h) (((b) * 2 + (h)) * HTB)
#define PG8_SB(b, h) ((4 + (b) * 2 + (h)) * HTB)
#define PG8_STAGE(bufoff, gbase, voff) do { _Pragma("unroll") for (int _i = 0; _i < 2; ++_i) \
        __builtin_amdgcn_global_load_lds((const unsigned*)((const char*)(gbase) + (voff)[_i]), (PG8_LAS unsigned*)(lds + (bufoff) + ldsw + _i * 8192), 16, 0, 0); } while (0)
#define PG8_LDA(dst, b, h) do { _Pragma("unroll") for (int m = 0; m < 4; ++m) _Pragma("unroll") for (int k = 0; k < 2; ++k) dst[m][k] = *(const PG8_LAS bf16x8*)(lds + PG8_SA(b, h) + aoff + m * 2048 + k * 1024); } while (0)
#define PG8_LDB(dst, b, h) do { _Pragma("unroll") for (int n = 0; n < 2; ++n) _Pragma("unroll") for (int k = 0; k < 2; ++k) dst[n][k] = *(const PG8_LAS bf16x8*)(lds + PG8_SB(b, h) + boff + n * 2048 + k * 1024); } while (0)
#define PG8_MMA(ai, bj, At, Bt) do { __builtin_amdgcn_s_setprio(1); _Pragma("unroll") for (int m = 0; m < 4; ++m) _Pragma("unroll") for (int n = 0; n < 2; ++n) _Pragma("unroll") for (int k = 0; k < 2; ++k) \
        acc[ai][bj][m][n] = __builtin_amdgcn_mfma_f32_16x16x32_bf16(Bt[n][k], At[m][k], acc[ai][bj][m][n], 0, 0, 0); __builtin_amdgcn_s_setprio(0); } while (0)
#define PG8_WAIT_V(n) asm volatile("s_waitcnt vmcnt(" #n ")" ::: "memory")
#define PG8_WAIT_L(n) asm volatile("s_waitcnt lgkmcnt(" #n ")" ::: "memory")
#define PG8_BAR __builtin_amdgcn_s_barrier()
#define PG8_SCHED __builtin_amdgcn_sched_barrier(0)
    Unit cur, nxt; int ui = 0;
    if (!S.next(0, cur)) return;
    f32x4 acc[2][2][4][2];
#pragma unroll
    for (int a = 0; a < 2; ++a)
#pragma unroll
        for (int b = 0; b < 2; ++b)
#pragma unroll
            for (int m = 0; m < 4; ++m)
#pragma unroll
                for (int n = 0; n < 2; ++n) acc[a][b][m][n] = (f32x4){0.f, 0.f, 0.f, 0.f};
    bf16x8 At[4][2], B0[2][2], B1[2][2];
    const char* cA = (const char*)g.A + (size_t)cur.pm * tstep; const char* cB = (const char*)g.Bt + (size_t)cur.pn * tstep;
    S.a_ready(cur);
    if constexpr (SP2) {
        PG8_STAGE(PG8_SB(0, 0), cB, voffB); PG8_STAGE(PG8_SB(0, 1), cB + hstep, voffB); PG8_STAGE(PG8_SA(0, 0), cA, voffA); PG8_STAGE(PG8_SA(0, 1), cA + hstep, voffA);
        if (wr == 1) PG8_BAR;
        PG8_WAIT_V(2); PG8_BAR;
        PG8_STAGE(PG8_SB(1, 0), cB + kstep, voffB); PG8_STAGE(PG8_SA(1, 0), cA + kstep, voffA); PG8_STAGE(PG8_SB(1, 1), cB + hstep + kstep, voffB);
        PG8_WAIT_V(6); PG8_BAR;
    } else {
        PG8_STAGE(PG8_SB(0, 0), cB, voffB); PG8_STAGE(PG8_SA(0, 0), cA, voffA); PG8_STAGE(PG8_SB(0, 1), cB + hstep, voffB); PG8_STAGE(PG8_SA(0, 1), cA + hstep, voffA);
        if (wr == 1) PG8_BAR;
        PG8_WAIT_V(4); PG8_BAR;
        PG8_STAGE(PG8_SB(1, 0), cB + kstep, voffB); PG8_STAGE(PG8_SA(1, 0), cA + kstep, voffA); PG8_STAGE(PG8_SB(1, 1), cB + hstep + kstep, voffB);
        PG8_WAIT_V(6); PG8_BAR;
    }
    for (;;) {
        const bool has_next = S.next(ui + 1, nxt);
        const char* nA = has_next ? (const char*)g.A + (size_t)nxt.pm * tstep : cA; const char* nB = has_next ? (const char*)g.Bt + (size_t)nxt.pn * tstep : cB;
        for (int t = 0; t < nt; t += 2) {
            const bool last = (t == nt - 2);
            const char* a1 = cA + (size_t)(t + 1) * kstep;
            const char* a2 = last ? nA : cA + (size_t)(t + 2) * kstep; const char* b2 = last ? nB : cB + (size_t)(t + 2) * kstep;
            const char* a3 = a2 + kstep; const char* b3 = b2 + kstep;
            if (last && has_next) S.a_ready(nxt);
            if constexpr (SP2) {
            PG8_LDB(B0, 0, 0); PG8_LDB(B1, 0, 1); PG8_SCHED; PG8_LDA(At, 0, 0); PG8_STAGE(PG8_SA(1, 1), a1 + hstep, voffA);
            PG8_WAIT_V(8); PG8_WAIT_L(0); PG8_BAR; PG8_MMA(0, 0, At, B0); PG8_MMA(0, 1, At, B1); PG8_BAR; PG8_SCHED;
            PG8_LDA(At, 0, 1); PG8_STAGE(PG8_SB(0, 0), b2, voffB); PG8_STAGE(PG8_SB(0, 1), b2 + hstep, voffB); PG8_STAGE(PG8_SA(0, 0), a2, voffA);
            PG8_WAIT_V(8); PG8_WAIT_L(0); PG8_BAR; PG8_MMA(1, 0, At, B0); PG8_MMA(1, 1, At, B1); PG8_BAR; PG8_SCHED;
            PG8_LDB(B0, 1, 0); PG8_LDB(B1, 1, 1); PG8_SCHED; PG8_LDA(At, 1, 0); PG8_STAGE(PG8_SA(0, 1), a2 + hstep, voffA);
            PG8_WAIT_V(8); PG8_WAIT_L(0); PG8_BAR; PG8_MMA(0, 0, At, B0); PG8_MMA(0, 1, At, B1); PG8_BAR; PG8_SCHED;
            PG8_LDA(At, 1, 1); PG8_STAGE(PG8_SB(1, 0), b3, voffB); PG8_STAGE(PG8_SB(1, 1), b3 + hstep, voffB); PG8_STAGE(PG8_SA(1, 0), a3, voffA);
            PG8_WAIT_V(8); PG8_WAIT_L(0); PG8_BAR; PG8_MMA(1, 0, At, B0); PG8_MMA(1, 1, At, B1); PG8_BAR; PG8_SCHED;
            } else {
            PG8_LDB(B0, 0, 0); PG8_SCHED; PG8_LDA(At, 0, 0); PG8_STAGE(PG8_SA(1, 1), a1 + hstep, voffA);
            PG8_WAIT_L(8); PG8_BAR; PG8_WAIT_L(0); PG8_MMA(0, 0, At, B0); PG8_BAR; PG8_SCHED;
            PG8_LDB(B1, 0, 1); PG8_STAGE(PG8_SB(0, 0), b2, voffB);
            PG8_BAR; PG8_WAIT_L(0); PG8_MMA(0, 1, At, B1); PG8_BAR;
            PG8_LDA(At, 0, 1); PG8_STAGE(PG8_SA(0, 0), a2, voffA);
            PG8_BAR; PG8_WAIT_L(0); PG8_MMA(1, 0, At, B0); PG8_BAR; PG8_SCHED;
            PG8_STAGE(PG8_SB(0, 1), b2 + hstep, voffB);
            PG8_WAIT_V(6); PG8_BAR; PG8_MMA(1, 1, At, B1); PG8_BAR;
            PG8_LDB(B0, 1, 0); PG8_SCHED; PG8_LDA(At, 1, 0); PG8_STAGE(PG8_SA(0, 1), a2 + hstep, voffA);
            PG8_WAIT_L(8); PG8_BAR; PG8_WAIT_L(0); PG8_MMA(0, 0, At, B0); PG8_BAR; PG8_SCHED;
            PG8_LDB(B1, 1, 1); PG8_STAGE(PG8_SB(1, 0), b3, voffB);
            PG8_BAR; PG8_WAIT_L(0); PG8_MMA(0, 1, At, B1); PG8_BAR;
            PG8_LDA(At, 1, 1); PG8_STAGE(PG8_SA(1, 0), a3, voffA);
            PG8_BAR; PG8_WAIT_L(0); PG8_MMA(1, 0, At, B0); PG8_BAR; PG8_SCHED;
            PG8_STAGE(PG8_SB(1, 1), b3 + hstep, voffB);
            PG8_WAIT_V(6); PG8_BAR; PG8_MMA(1, 1, At, B1); PG8_BAR;
            }
        }
        if constexpr (ALIGN_EPI) { if (wr == 0) PG8_BAR; }
        if constexpr (!Epi::AFTER_DRAIN) { E(acc, cur, wr, wc, fr, fq); S.done(cur); }
        if (!has_next) break;
#pragma unroll
        for (int a = 0; a < 2; ++a)
#pragma unroll
            for (int b = 0; b < 2; ++b)
#pragma unroll
                for (int m = 0; m < 4; ++m)
#pragma unroll
                    for (int n = 0; n < 2; ++n) acc[a][b][m][n] = (f32x4){0.f, 0.f, 0.f, 0.f};
        cur = nxt; cA = nA; cB = nB; ++ui;
        if constexpr (ALIGN_EPI) { if (wr == 1) PG8_BAR; }
    }
    PG8_WAIT_V(0);
    if constexpr (!ALIGN_EPI) { if (wr == 0) PG8_BAR; }
    PG8_BAR;
    if constexpr (Epi::AFTER_DRAIN) { E.fused(acc, cur, wr, wc, fr, fq, lds, wid, lane); S.done(cur); }
#undef PG8_SA
#undef PG8_SB
#undef PG8_STAGE
#undef PG8_LDA
#undef PG8_LDB
#undef PG8_MMA
#undef PG8_WAIT_V
#undef PG8_WAIT_L
#undef PG8_BAR
#undef PG8_SCHED
}
}
constexpr int NWAVES = 8, NTHR = NWAVES * 64;
constexpr int D = 2048, SEQ = 2048, NB = 4, TP = NB * SEQ, DB = 32, DSEQ = 8, TS = DB * DSEQ, MT = TP + TS, PAST = 8192;
constexpr int EVEN_IN = 15360, EVEN_OUT = 3072, ODD_IN = 12352, ODD_INP = 12544, GDN_VW = 4096, CONV_CH = 8192, MEM_W = 512, DFF = 8192, MEMT = 256;
constexpr int C_QR = 0, C_KR = 1024, C_VR = 2048, C_GR = 4096, C_QS = 6144, C_KS = 9216, C_VS = 12288;
constexpr int C_Z = 8192, C_BETA = 12288, C_AIN = 12320;
constexpr float EPS = 1e-6f, LOG2E = 1.4426950408889634f;
enum { I_XP = 0, I_XS, I_MEM, I_SRET, I_C1, I_C2, I_C3, I_SGDN, I_SCONV, I_CMEM, I_NMIX, I_NMEM, I_NMEMSRC, I_NFFN, I_WINE, I_GNW, I_SQN, I_SKN, I_RELB, I_WOUTE,
       I_WINO, I_CONVW, I_ALOG, I_DTB, I_GDNNW, I_WOUTO, I_MWQ, I_MWKV, I_MQN, I_MKN, I_MWO, I_W1, I_W2, N_IN };
constexpr size_t O_Y = 0, O_RETP = O_Y + (size_t)MT * D, O_RETS = O_RETP + (size_t)NB * 8 * 128 * 256, O_S1P = O_RETS + (size_t)DB * 8 * 128 * 256,
    O_S1S = O_S1P + (size_t)NB * 128 * 2048, O_S2P = O_S1S + (size_t)DB * 8 * 2048, O_S2S = O_S2P + (size_t)NB * 512 * 2048, O_S3P = O_S2S + (size_t)DB * 8 * 2048,
    O_S3S = O_S3P + (size_t)NB * 2048 * 2048, O_GDNP = O_S3S + (size_t)DB * 8 * 2048, O_GDNS = O_GDNP + (size_t)NB * 32 * 128 * 128, O_CONVP = O_GDNS + (size_t)DB * 32 * 128 * 128,
    O_CONVS = O_CONVP + (size_t)NB * 3 * CONV_CH, O_MEMP = O_CONVS + (size_t)DB * 3 * CONV_CH, O_END = O_MEMP + (size_t)2 * NB * MEMT * 1024;
static_assert(O_END == 72187904, "output size");
constexpr size_t MiB = 1u << 20;
constexpr size_t WS_CTL = 0, CTL_ZERO_BYTES = 1 * MiB;
constexpr size_t WS_ROPE = 1 * MiB, WS_BIAS = 3 * MiB;
constexpr size_t WS_WINE = 4 * MiB, WS_WOUTE = WS_WINE + 60 * MiB, WS_WINO = WS_WOUTE + 12 * MiB, WS_WOUTO = WS_WINO + 49 * MiB, WS_WL = WS_WOUTO + 16 * MiB;
constexpr size_t WL_Q = 0, WL_KV = 2 * MiB, WL_O = 6 * MiB, WL_1 = 8 * MiB, WL_2 = 40 * MiB, WL_SZ = 72 * MiB;
constexpr size_t WS_U = 288 * MiB, WS_PROJ = 322 * MiB, WS_YC = 570 * MiB, WS_QM = 636 * MiB, WS_OM = 645 * MiB, WS_KVRAW = 654 * MiB, WS_KVP = 662 * MiB, WS_MEMN = 666 * MiB;
constexpr size_t WS_QN = 674 * MiB, WS_KN = 707 * MiB, WS_VV = 740 * MiB, WS_UC = 806 * MiB, WS_WC = 872 * MiB, WS_ATT = 938 * MiB, WS_GB = 970 * MiB, WS_GG = 972 * MiB, WS_GC = 974 * MiB, WS_END = 976 * MiB;
static_assert(WS_WL + 2 * WL_SZ <= WS_U, "weights");
constexpr int CW_BAR = 4096, CW_Q = 16384;
constexpr int RING_OFF = 0, RING_BYTES = 131072, LDSCTL_OFF = RING_BYTES, MISC_OFF = LDSCTL_OFF + 320, LDS_BYTES = 147456;

#define GAS __attribute__((address_space(1)))
#define LAS __attribute__((address_space(3)))
#define DI __device__ __forceinline__
typedef unsigned short bf16;
typedef unsigned v4u __attribute__((ext_vector_type(4)));
typedef unsigned v2u __attribute__((ext_vector_type(2)));
typedef float f32x4 __attribute__((ext_vector_type(4)));
typedef float f32x2 __attribute__((ext_vector_type(2)));
typedef short bf16x8 __attribute__((ext_vector_type(8)));
typedef short s16x4 __attribute__((ext_vector_type(4)));
typedef GAS unsigned gu32;
#define RLX_AGENT __ATOMIC_RELAXED, __HIP_MEMORY_SCOPE_AGENT
#define LDS_WAIT() asm volatile("s_waitcnt lgkmcnt(0)" ::: "memory")
#define VM_WAIT() asm volatile("s_waitcnt vmcnt(0)" ::: "memory")
DI unsigned f2bf(float f) { unsigned u = __builtin_bit_cast(unsigned, f); return (u + 0x7fffu + ((u >> 16) & 1u)) >> 16; }
DI unsigned pk2(float lo, float hi) { unsigned r; asm volatile("v_cvt_pk_bf16_f32 %0, %1, %2" : "=v"(r) : "v"(lo), "v"(hi)); return r; }
DI float bflo(unsigned w) { return __builtin_bit_cast(float, w << 16); }
DI float bfhi(unsigned w) { return __builtin_bit_cast(float, w & 0xffff0000u); }
DI float bf2f(bf16 b) { return __builtin_bit_cast(float, ((unsigned)b) << 16); }
DI float wave_sum(float v) {
#pragma unroll
    for (int o = 1; o < 64; o <<= 1) v += __shfl_xor(v, o);
    return v;
}
DI float silu(float x) { return x / (1.f + __expf(-x)); }
#define XB_TMO      128
#define XB_XCNT(j)  (256  + 64 * (j))
#define XB_XSUB(j)  (1280 + 64 * (j))
#define XB_XGEN(j)  (2304 + 64 * (j))
#define XB_TOP      3328
#define XB_TOPGEN   3392
#define XCD_BAR_WORDS 3456
#define XB_SPIN_CAP (1u << 18)

__device__ __forceinline__ unsigned xb_ld(unsigned* p)              { return __hip_atomic_load(p, __ATOMIC_RELAXED, __HIP_MEMORY_SCOPE_AGENT); }
__device__ __forceinline__ unsigned xb_add(unsigned* p, unsigned v) { return __hip_atomic_fetch_add(p, v, __ATOMIC_RELAXED, __HIP_MEMORY_SCOPE_AGENT); }
__device__ __forceinline__ unsigned xb_xcc_id() { return (unsigned)__builtin_amdgcn_s_getreg((3 << 11) | 20) & 0xFu; }
#define XB_SPIN(cond, bar) do { unsigned _sp = 0; while (cond) { __builtin_amdgcn_s_sleep(1); \
    if ((++_sp & 255u) == 0u) { if (xb_ld(&(bar)[XB_TMO])) break; if (_sp > XB_SPIN_CAP) { atomicAdd(&(bar)[XB_TMO], 1u); break; } } } } while (0)

struct XcdBarrier {
    unsigned* bar; unsigned x;
    volatile LAS unsigned* st;
};

__device__ __forceinline__ XcdBarrier xcd_barrier_post(unsigned* bar, volatile LAS unsigned* st) {
    XcdBarrier b; b.bar = bar; b.x = xb_xcc_id(); b.st = st;
    if (threadIdx.x == 0) (void)xb_add(&bar[XB_XCNT(b.x)], 1u);
    return b;
}
__device__ __forceinline__ void xcd_barrier_complete(unsigned* bar, unsigned x, unsigned& nloc, unsigned& nx) {
    const unsigned G = gridDim.x * gridDim.y * gridDim.z;
    unsigned sum, cnt, mine, sp = 0u;
    for (;;) {
        sum = 0u; cnt = 0u; mine = 0u;
#pragma unroll
        for (unsigned j = 0; j < 16; ++j) { const unsigned c = xb_ld(&bar[XB_XCNT(j)]); sum += c; cnt += (c > 0u) ? 1u : 0u; mine = (j == x) ? c : mine; }
        if (sum == G) break;
        __builtin_amdgcn_s_sleep(1);
        if ((++sp & 255u) == 0u) { if (xb_ld(&bar[XB_TMO])) break; if (sp > XB_SPIN_CAP) { atomicAdd(&bar[XB_TMO], 1u); break; } }
    }
    nloc = mine > 0u ? mine : 1u; nx = cnt > 0u ? cnt : 1u;
}

__device__ __forceinline__ void xcd_barrier(const XcdBarrier& b) {
    asm volatile("s_waitcnt vmcnt(0)" ::: "memory");
    __syncthreads();
    if (threadIdx.x == 0) {
        unsigned* bar = b.bar;
        __builtin_amdgcn_s_waitcnt(0);
        unsigned nloc = b.st[0], nx = b.st[1];
        if (nloc == 0u) { xcd_barrier_complete(bar, b.x, nloc, nx); b.st[0] = nloc; b.st[1] = nx; }
        const unsigned old = xb_add(&bar[XB_XSUB(b.x)], 1u);
        const unsigned gen = old / nloc;
        if (old + 1u == (gen + 1u) * nloc) {
            __builtin_amdgcn_fence(__ATOMIC_RELEASE, "agent");
            asm volatile("s_waitcnt vmcnt(0)" ::: "memory");
            const unsigned og = xb_add(&bar[XB_TOP], 1u);
            const unsigned tg = og / nx;
            if (og + 1u == (tg + 1u) * nx) xb_add(&bar[XB_TOPGEN], 1u);
            else XB_SPIN(xb_ld(&bar[XB_TOPGEN]) == tg, bar);
            __builtin_amdgcn_fence(__ATOMIC_ACQUIRE, "agent");
            xb_add(&bar[XB_XGEN(b.x)], 1u);
            asm volatile("s_waitcnt vmcnt(0)" ::: "memory");
        } else {
            XB_SPIN(xb_ld(&bar[XB_XGEN(b.x)]) == gen, bar);
            __builtin_amdgcn_fence(__ATOMIC_ACQUIRE, "agent");
            asm volatile("s_waitcnt vmcnt(0)" ::: "memory");
        }
    }
    __syncthreads();
}
struct Args { const float* in[N_IN]; float* out; unsigned char* ws; int ph_lo, ph_hi; };
static_assert(sizeof(Args) == N_IN * 8 + 24, "Args has no padding");
struct Frame {
    LAS unsigned char* lds;
    volatile LAS unsigned* MISC;
    gu32* ctl;
    int tid, lane, wave, G, bx;
};
DI int gwave(const Frame& F) { return F.bx * NWAVES + F.wave; }
DI int ngwave(const Frame& F) { return F.G * NWAVES; }

DI void p0_transpose_item(const float* W, int K, int N, bf16* WT, LAS float* scr, int item, int lane) {
    const int nblk = N / 32, kb = item / nblk, nb = item % nblk, k0 = 64 * kb, n0 = 32 * nb;
#pragma unroll 8
    for (int i = 0; i < 32; ++i) { const int kk = 2 * i + (lane >> 5); scr[kk * 33 + (lane & 31)] = W[(size_t)(k0 + kk) * N + n0 + (lane & 31)]; }
    LDS_WAIT(); asm volatile("" ::: "memory");
    const int c = lane & 7;
#pragma unroll
    for (int j = 0; j < 4; ++j) { const int n = (lane >> 3) + 8 * j; const LAS float* s = scr + (8 * c) * 33 + n;
        v4u o; o.x = pk2(s[0 * 33], s[1 * 33]); o.y = pk2(s[2 * 33], s[3 * 33]); o.z = pk2(s[4 * 33], s[5 * 33]); o.w = pk2(s[6 * 33], s[7 * 33]);
        *(GAS v4u*)(WT + (size_t)(n0 + n) * K + k0 + 8 * c) = o; }
    LDS_WAIT(); asm volatile("" ::: "memory");
}
DI void p0_mat(const Frame& F, const float* W, int K, int N, bf16* WT, LAS float* scr, int rot) {
    const int NGW = ngwave(F); const int gw = (gwave(F) + rot) % NGW;
    const int nitems = (K / 64) * (N / 32);
    for (int it = gw; it < nitems; it += NGW) p0_transpose_item(W, K, N, WT, scr, it, F.lane);
}
DI void rms_row(const float* xrow, const float* gain, bf16* orow, float* hrow, int lane) {
    const GAS f32x4* xr = (const GAS f32x4*)xrow + lane; const GAS f32x4* gr = (const GAS f32x4*)gain + lane;
    f32x4 v[8]; float s = 0.f;
#pragma unroll
    for (int j = 0; j < 8; ++j) { v[j] = xr[64 * j]; s += (v[j].x * v[j].x + v[j].y * v[j].y) + (v[j].z * v[j].z + v[j].w * v[j].w); }
    const float rs = rsqrtf(wave_sum(s) * (1.f / D) + EPS);
    if (hrow) { GAS f32x4* hr = (GAS f32x4*)hrow + lane;
#pragma unroll
        for (int j = 0; j < 8; ++j) hr[64 * j] = v[j]; }
    GAS v2u* o8 = (GAS v2u*)orow + lane;
#pragma unroll
    for (int j = 0; j < 8; ++j) { const f32x4 g = gr[64 * j]; v2u w; w.x = pk2(v[j].x * rs * g.x, v[j].y * rs * g.y); w.y = pk2(v[j].z * rs * g.z, v[j].w * rs * g.w); o8[64 * j] = w; }
}
DI void ph_prologue(const Args& A, Frame& F) {
    LAS float* scr = (LAS float*)(F.lds + RING_OFF + F.wave * 16384);
    unsigned char* ws = A.ws;
    p0_mat(F, A.in[I_WINE], D, EVEN_IN, (bf16*)(ws + WS_WINE), scr, 0);
    p0_mat(F, A.in[I_WOUTE], EVEN_OUT, D, (bf16*)(ws + WS_WOUTE), scr, 300);
    p0_mat(F, A.in[I_WINO], D, ODD_IN, (bf16*)(ws + WS_WINO), scr, 600);
    p0_mat(F, A.in[I_WOUTO], GDN_VW, D, (bf16*)(ws + WS_WOUTO), scr, 900);
#pragma unroll
    for (int li = 0; li < 2; ++li) {
        unsigned char* wl = ws + WS_WL + li * WL_SZ;
        p0_mat(F, A.in[I_MWQ] + (size_t)li * D * MEM_W, D, MEM_W, (bf16*)(wl + WL_Q), scr, 1200);
        p0_mat(F, A.in[I_MWKV] + (size_t)li * D * 1024, D, 1024, (bf16*)(wl + WL_KV), scr, 1300);
        p0_mat(F, A.in[I_MWO] + (size_t)li * MEM_W * D, MEM_W, D, (bf16*)(wl + WL_O), scr, 1500);
        p0_mat(F, A.in[I_W1] + (size_t)li * D * DFF, D, DFF, (bf16*)(wl + WL_1), scr, 0);
        p0_mat(F, A.in[I_W2] + (size_t)li * DFF * D, DFF, D, (bf16*)(wl + WL_2), scr, 1000);
    }
    const int gw = gwave(F), NGW = ngwave(F);
    { GAS v4u* z = (GAS v4u*)(ws + WS_WINO + (size_t)ODD_IN * D * 2); const int n16 = (ODD_INP - ODD_IN) * D * 2 / 16;
      for (int i = gw * 64 + F.lane; i < n16; i += NGW * 64) z[i] = (v4u){0u, 0u, 0u, 0u}; }
    for (int m = gw; m < MT; m += NGW) {
        const float* xr = m < TP ? A.in[I_XP] + (size_t)m * D : A.in[I_XS] + (size_t)(m - TP) * D;
        rms_row(xr, A.in[I_NMIX], (bf16*)(ws + WS_U) + (size_t)m * D, A.out + O_Y + (size_t)m * D, F.lane);
    }
    for (int r = gw; r < 2 * NB * MEMT; r += NGW) { const int li = r / (NB * MEMT), mr = r % (NB * MEMT);
        rms_row(A.in[I_MEM] + (size_t)mr * D, A.in[I_NMEMSRC] + li * D, (bf16*)(ws + WS_MEMN) + (size_t)r * D, nullptr, F.lane); }
    { f32x2* rope = (f32x2*)(ws + WS_ROPE);
      for (int e = gw * 64 + F.lane; e < (SEQ + DSEQ) * 64; e += NGW * 64) { const int idx = e >> 6, i = e & 63; const int pos = idx < SEQ ? idx : PAST + idx - SEQ;
          const float inv = exp2f(-(float)i * (13.287712379549449f / 64.f)); const float ang = (float)pos * inv;
          const double rev = (double)ang * 0.15915494309189535; const float fr = (float)(rev - floor(rev));
          rope[e] = (f32x2){__builtin_amdgcn_cosf(fr), __builtin_amdgcn_sinf(fr)}; } }
    { float* bt = (float*)(ws + WS_BIAS);
      for (int e = gw * 64 + F.lane; e < 3 * 8 * 129; e += NGW * 64) { const int gi = e / (8 * 129), hh = (e / 129) % 8, m = e % 129; const int dist = m * (gi == 0 ? 1 : gi == 1 ? 4 : 16);
          int bk; if (dist < 16) bk = dist; else { const double dd = (double)dist; bk = 16 + (int)(log(dd / 16.0) / log(128.0) * 16.0); bk = bk > 31 ? 31 : bk; }
          bt[e] = A.in[I_RELB][bk * 24 + gi * 8 + hh] * LOG2E; } }
}
DI void ph_rmsnorm(const Args& A, Frame& F, const float* gain) {
    const int gw = gwave(F), NGW = ngwave(F);
    for (int m = gw; m < MT; m += NGW) rms_row(A.out + O_Y + (size_t)m * D, gain, (bf16*)(A.ws + WS_U) + (size_t)m * D, nullptr, F.lane);
}
DI void unpack16(const v4u a, const v4u b, float (&x)[16]) {
    x[0] = bflo(a.x); x[1] = bfhi(a.x); x[2] = bflo(a.y); x[3] = bfhi(a.y); x[4] = bflo(a.z); x[5] = bfhi(a.z); x[6] = bflo(a.w); x[7] = bfhi(a.w);
    x[8] = bflo(b.x); x[9] = bfhi(b.x); x[10] = bflo(b.y); x[11] = bfhi(b.y); x[12] = bflo(b.z); x[13] = bfhi(b.z); x[14] = bflo(b.w); x[15] = bfhi(b.w);
}
DI void ph_post_even(const Args& A, Frame& F) {
    const int gw = gwave(F), NGW = ngwave(F), lane = F.lane;
    bf16* proj = (bf16*)(A.ws + WS_PROJ);
    for (int it = gw; it < MT * 3; it += NGW) {
        const int m = it / 3, gi = it % 3;
        bf16* kp = proj + (size_t)m * EVEN_IN + C_KS + gi * 1024 + 16 * lane; const bf16* vp = proj + (size_t)m * EVEN_IN + C_VS + gi * 1024 + 16 * lane;
        const v4u k0 = *(const GAS v4u*)kp, k1 = *(const GAS v4u*)(kp + 8), v0 = *(const GAS v4u*)vp, v1 = *(const GAS v4u*)(vp + 8);
        float k[16], v[16]; unpack16(k0, k1, k); unpack16(v0, v1, v);
        float ss = 0.f;
#pragma unroll
        for (int j = 0; j < 16; ++j) ss += k[j] * k[j];
        ss += __shfl_xor(ss, 1); ss += __shfl_xor(ss, 2); ss += __shfl_xor(ss, 4);
        const float rs = rsqrtf(ss * (1.f / 128.f) + EPS);
        const GAS f32x4* wp = (const GAS f32x4*)(A.in[I_SKN] + ((16 * lane) & 127));
#pragma unroll
        for (int q = 0; q < 4; ++q) { const f32x4 w = wp[q]; k[4 * q] *= rs * w.x; k[4 * q + 1] *= rs * w.y; k[4 * q + 2] *= rs * w.z; k[4 * q + 3] *= rs * w.w; }
        v4u o0, o1; o0.x = pk2(k[0], k[1]); o0.y = pk2(k[2], k[3]); o0.z = pk2(k[4], k[5]); o0.w = pk2(k[6], k[7]); o1.x = pk2(k[8], k[9]); o1.y = pk2(k[10], k[11]); o1.z = pk2(k[12], k[13]); o1.w = pk2(k[14], k[15]);
        *(GAS v4u*)kp = o0; *(GAS v4u*)(kp + 8) = o1;
        float* dst = nullptr;
        if (m < TP) { const int b = m / SEQ, t = m % SEQ; const int keep = gi == 0 ? 128 : gi == 1 ? 512 : 2048; const size_t ob = gi == 0 ? O_S1P : gi == 1 ? O_S2P : O_S3P;
            if (t >= SEQ - keep) dst = A.out + ob + ((size_t)(b * keep + t - (SEQ - keep)) * 2) * 1024 + 16 * lane; }
        else { const size_t ob = gi == 0 ? O_S1S : gi == 1 ? O_S2S : O_S3S; dst = A.out + ob + ((size_t)(m - TP) * 2) * 1024 + 16 * lane; }
        if (dst) {
#pragma unroll
            for (int q = 0; q < 4; ++q) { *(GAS f32x4*)(dst + 4 * q) = (f32x4){k[4 * q], k[4 * q + 1], k[4 * q + 2], k[4 * q + 3]}; *(GAS f32x4*)(dst + 1024 + 4 * q) = (f32x4){v[4 * q], v[4 * q + 1], v[4 * q + 2], v[4 * q + 3]}; } }
    }
    for (int r = gw; r < 2 * NB * MEMT; r += NGW) { const int li = r / (NB * MEMT);
        const float* src = (const float*)(A.ws + WS_KVRAW) + (size_t)r * 1024 + 16 * lane;
        float x[16];
#pragma unroll
        for (int q = 0; q < 4; ++q) { const f32x4 t = *(const GAS f32x4*)(src + 4 * q); x[4 * q] = t.x; x[4 * q + 1] = t.y; x[4 * q + 2] = t.z; x[4 * q + 3] = t.w; }
        float ss = 0.f;
#pragma unroll
        for (int j = 0; j < 16; ++j) ss += x[j] * x[j];
        ss += __shfl_xor(ss, 1); ss += __shfl_xor(ss, 2); ss += __shfl_xor(ss, 4);
        const float rs = rsqrtf(ss * (1.f / 128.f) + EPS);
        const GAS f32x4* wp = (const GAS f32x4*)(A.in[I_MKN] + li * 128 + ((16 * lane) & 127));
        if (lane < 32) {
#pragma unroll
            for (int q = 0; q < 4; ++q) { const f32x4 w = wp[q]; x[4 * q] *= rs * w.x; x[4 * q + 1] *= rs * w.y; x[4 * q + 2] *= rs * w.z; x[4 * q + 3] *= rs * w.w; } }
        float* dst = A.out + O_MEMP + (size_t)r * 1024 + 16 * lane;
#pragma unroll
        for (int q = 0; q < 4; ++q) *(GAS f32x4*)(dst + 4 * q) = (f32x4){x[4 * q], x[4 * q + 1], x[4 * q + 2], x[4 * q + 3]};
        v4u o0, o1; o0.x = pk2(x[0], x[1]); o0.y = pk2(x[2], x[3]); o0.z = pk2(x[4], x[5]); o0.w = pk2(x[6], x[7]); o1.x = pk2(x[8], x[9]); o1.y = pk2(x[10], x[11]); o1.z = pk2(x[12], x[13]); o1.w = pk2(x[14], x[15]);
        bf16* kd = (bf16*)(A.ws + WS_KVP) + (size_t)r * 1024 + 16 * lane; *(GAS v4u*)kd = o0; *(GAS v4u*)(kd + 8) = o1;
    }
}
#define MFMA16(a, b, c) __builtin_amdgcn_mfma_f32_16x16x32_bf16((a), (b), (c), 0, 0, 0)
constexpr int LDV = 136;
constexpr int VIMG_BYTES = 32 * LDV * 2;
struct KeyEnum {
    const char* kbase;
    long stride;
    int voff;
    int p0, sh, a;
    int pbase, nk;
};
struct MaskP { int dmask, dshift, win; const float* bias; int nomask; };
DI int kpos_of(const KeyEnum& E, int kk) { return E.p0 + (kk >> E.sh) * E.a + (kk & ((1 << E.sh) - 1)); }
DI s16x4 tr16(const LAS unsigned char* p) { return __builtin_amdgcn_ds_read_tr16_b64_v4i16((LAS s16x4*)p); }
DI bf16x8 cat4(s16x4 a, s16x4 b) { return (bf16x8){a[0], a[1], a[2], a[3], b[0], b[1], b[2], b[3]}; }
DI bf16x8 cvt8(f32x4 a, f32x4 b) { v4u r; r.x = pk2(a.x, a.y); r.y = pk2(a.z, a.w); r.z = pk2(b.x, b.y); r.w = pk2(b.z, b.w); return __builtin_bit_cast(bf16x8, r); }

template <bool F32>
DI void attn_keys(f32x4 (&o)[8], float& mrun, float& lrun, const bf16x8 (&bq)[4], const KeyEnum& E, const MaskP& Mk, int qpos, LAS unsigned char* vimg, int lane) {
    const int c = lane & 15, g = lane >> 4;
    const int nch = (E.nk + 31) >> 5;
    const LAS unsigned char* trb = vimg + ((4 * g + (c >> 2)) * LDV + 4 * (c & 3)) * 2;
    for (int ch = 0; ch < nch; ++ch) {
        bf16x8 ak[2][4];
#pragma unroll
        for (int kt = 0; kt < 2; ++kt) { int kk = ch * 32 + kt * 16 + c; kk = kk < E.nk ? kk : E.nk - 1; const char* rp = E.kbase + (long)(kpos_of(E, kk) - E.pbase) * E.stride;
#pragma unroll
            for (int ks = 0; ks < 4; ++ks) {
                if constexpr (F32) { const f32x4 x0 = *(const GAS f32x4*)(rp + (32 * ks + 8 * g) * 4), x1 = *(const GAS f32x4*)(rp + (32 * ks + 8 * g) * 4 + 16); ak[kt][ks] = cvt8(x0, x1); }
                else ak[kt][ks] = __builtin_bit_cast(bf16x8, *(const GAS v4u*)(rp + (32 * ks + 8 * g) * 2)); } }
#pragma unroll
        for (int it = 0; it < 8; ++it) { int kk = ch * 32 + it * 4 + g; kk = kk < E.nk ? kk : E.nk - 1; const char* rp = E.kbase + (long)(kpos_of(E, kk) - E.pbase) * E.stride + E.voff;
            v4u w;
            if constexpr (F32) { const f32x4 x0 = *(const GAS f32x4*)(rp + c * 32), x1 = *(const GAS f32x4*)(rp + c * 32 + 16); w = __builtin_bit_cast(v4u, cvt8(x0, x1)); }
            else w = *(const GAS v4u*)(rp + c * 16);
            *(LAS v4u*)(vimg + ((it * 4 + g) * LDV + c * 8) * 2) = w; }
        f32x4 s[2];
#pragma unroll
        for (int kt = 0; kt < 2; ++kt) { s[kt] = (f32x4){0.f, 0.f, 0.f, 0.f};
#pragma unroll
            for (int ks = 0; ks < 4; ++ks) s[kt] = MFMA16(ak[kt][ks], bq[ks], s[kt]); }
        float mx = -INFINITY;
#pragma unroll
        for (int kt = 0; kt < 2; ++kt)
#pragma unroll
            for (int r = 0; r < 4; ++r) { const int kk = ch * 32 + kt * 16 + 4 * g + r; float v = s[kt][r]; bool ok = kk < E.nk;
                if (!Mk.nomask) { const int diff = qpos - kpos_of(E, kk); ok = ok && diff >= 0 && (diff & Mk.dmask) == 0 && diff <= Mk.win; int mi = diff >> Mk.dshift; mi = mi < 0 ? 0 : (mi > 128 ? 128 : mi); v += Mk.bias[mi]; }
                v = ok ? v : -INFINITY; s[kt][r] = v; mx = fmaxf(mx, v); }
        mx = fmaxf(mx, __shfl_xor(mx, 16)); mx = fmaxf(mx, __shfl_xor(mx, 32));
        const float mnew = fmaxf(mrun, mx), muse = mnew == -INFINITY ? 0.f : mnew;
        const float alpha = exp2f(mrun - muse);
        mrun = mnew;
        float ps = 0.f; v4u pp;
        { float p[8];
#pragma unroll
          for (int kt = 0; kt < 2; ++kt)
#pragma unroll
              for (int r = 0; r < 4; ++r) { p[kt * 4 + r] = exp2f(s[kt][r] - muse); ps += p[kt * 4 + r]; }
          pp.x = pk2(p[0], p[1]); pp.y = pk2(p[2], p[3]); pp.z = pk2(p[4], p[5]); pp.w = pk2(p[6], p[7]); }
        lrun = lrun * alpha + ps;
        const bf16x8 pb = __builtin_bit_cast(bf16x8, pp);
#pragma unroll
        for (int dt = 0; dt < 8; ++dt) { const bf16x8 av = cat4(tr16(trb + dt * 32), tr16(trb + dt * 32 + 16 * LDV * 2));
            o[dt] = o[dt] * alpha; o[dt] = MFMA16(av, pb, o[dt]); }
    }
}
DI void attn_load_q(bf16x8 (&bq)[4], const bf16* qrow, const float* w, float sc, int lane) {
    const int g = lane >> 4; float x[4][8]; float ss = 0.f;
#pragma unroll
    for (int ks = 0; ks < 4; ++ks) { const v4u t = *(const GAS v4u*)(qrow + 32 * ks + 8 * g);
        x[ks][0] = bflo(t.x); x[ks][1] = bfhi(t.x); x[ks][2] = bflo(t.y); x[ks][3] = bfhi(t.y); x[ks][4] = bflo(t.z); x[ks][5] = bfhi(t.z); x[ks][6] = bflo(t.w); x[ks][7] = bfhi(t.w);
#pragma unroll
        for (int j = 0; j < 8; ++j) ss += x[ks][j] * x[ks][j]; }
    ss += __shfl_xor(ss, 16); ss += __shfl_xor(ss, 32);
    const float rs = rsqrtf(ss * (1.f / 128.f) + EPS) * sc;
#pragma unroll
    for (int ks = 0; ks < 4; ++ks) { const f32x4 w0 = *(const GAS f32x4*)(w + 32 * ks + 8 * g), w1 = *(const GAS f32x4*)(w + 32 * ks + 8 * g + 4);
        bq[ks] = cvt8((f32x4){x[ks][0] * rs * w0.x, x[ks][1] * rs * w0.y, x[ks][2] * rs * w0.z, x[ks][3] * rs * w0.w}, (f32x4){x[ks][4] * rs * w1.x, x[ks][5] * rs * w1.y, x[ks][6] * rs * w1.z, x[ks][7] * rs * w1.w}); }
}
DI void attn_store(const f32x4 (&o)[8], float lrun, bf16* orow, int lane, bool write) {
    const int g = lane >> 4; float l = lrun; l += __shfl_xor(l, 16); l += __shfl_xor(l, 32); const float inv = 1.f / l;
    if (write) {
#pragma unroll
        for (int dt = 0; dt < 8; ++dt) { v2u w; w.x = pk2(o[dt].x * inv, o[dt].y * inv); w.y = pk2(o[dt].z * inv, o[dt].w * inv); *(GAS v2u*)(orow + 16 * dt + 4 * g) = w; } }
}
DI void swa_prompt_tile(const Args& A, Frame& F, int b, int hh, int blk, int r, LAS unsigned char* vimg) {
    const int lane = F.lane, c = lane & 15;
    const bf16* proj = (const bf16*)(A.ws + WS_PROJ);
    const int tq = 256 * blk + r + 16 * c; const size_t m = (size_t)b * SEQ + tq;
    f32x4 o[8];
#pragma unroll
    for (int i = 0; i < 8; ++i) o[i] = (f32x4){0.f, 0.f, 0.f, 0.f};
    float mrun = -INFINITY, lrun = 0.f;
    for (int gi = 0; gi < 3; ++gi) {
        const int dsh = 2 * gi, dil = 1 << dsh, win = 128 << dsh;
        bf16x8 bq[4]; attn_load_q(bq, proj + m * EVEN_IN + C_QS + gi * 1024 + hh * 128, A.in[I_SQN], 0.08838834764831845f * LOG2E, lane);
        const int tmin = 256 * blk + r, tmax = tmin + 240; int plo = tmin - win; const int pfl = r & (dil - 1); plo = plo < pfl ? pfl : plo;
        KeyEnum E; E.kbase = (const char*)(proj + (size_t)b * SEQ * EVEN_IN + C_KS + gi * 1024 + hh * 128); E.stride = (long)EVEN_IN * 2; E.voff = (C_VS - C_KS) * 2;
        E.p0 = plo; E.sh = 0; E.a = dil; E.pbase = 0; E.nk = ((tmax - plo) >> dsh) + 1;
        MaskP Mk; Mk.dmask = dil - 1; Mk.dshift = dsh; Mk.win = win; Mk.bias = (const float*)(A.ws + WS_BIAS) + (gi * 8 + hh) * 129; Mk.nomask = 0;
        attn_keys<false>(o, mrun, lrun, bq, E, Mk, tq, vimg, lane);
    }
    attn_store(o, lrun, (bf16*)(A.ws + WS_YC) + m * EVEN_OUT + 2048 + hh * 128, lane, true);
}
DI void swa_sample_tile(const Args& A, Frame& F, int b, int hh, LAS unsigned char* vimg) {
    const int lane = F.lane, c = lane & 15, qi = c & 7;
    const bf16* proj = (const bf16*)(A.ws + WS_PROJ);
    const size_t m = (size_t)TP + b * DSEQ + qi; const int qpos = PAST + qi;
    f32x4 o[8];
#pragma unroll
    for (int i = 0; i < 8; ++i) o[i] = (f32x4){0.f, 0.f, 0.f, 0.f};
    float mrun = -INFINITY, lrun = 0.f;
    for (int gi = 0; gi < 3; ++gi) {
        const int dsh = 2 * gi, dil = 1 << dsh, win = 128 << dsh, L = win;
        bf16x8 bq[4]; attn_load_q(bq, proj + m * EVEN_IN + C_QS + gi * 1024 + hh * 128, A.in[I_SQN], 0.08838834764831845f * LOG2E, lane);
        MaskP Mk; Mk.dmask = dil - 1; Mk.dshift = dsh; Mk.win = win; Mk.bias = (const float*)(A.ws + WS_BIAS) + (gi * 8 + hh) * 129; Mk.nomask = 0;
        const float* cache = gi == 0 ? A.in[I_C1] : gi == 1 ? A.in[I_C2] : A.in[I_C3];
        KeyEnum E; E.kbase = (const char*)(cache + (size_t)b * L * 2048 + hh * 128); E.stride = 2048 * 4; E.voff = 1024 * 4; E.pbase = PAST - L; E.p0 = PAST - L;
        if (gi == 2) { E.sh = 3; E.a = 16; E.nk = 1024; } else { E.sh = 0; E.a = 1; E.nk = L; }
        attn_keys<true>(o, mrun, lrun, bq, E, Mk, qpos, vimg, lane);
        KeyEnum N; N.kbase = (const char*)(proj + ((size_t)TP + b * DSEQ) * EVEN_IN + C_KS + gi * 1024 + hh * 128); N.stride = (long)EVEN_IN * 2; N.voff = (C_VS - C_KS) * 2;
        N.pbase = PAST; N.p0 = PAST; N.sh = 0; N.a = 1; N.nk = DSEQ;
        attn_keys<false>(o, mrun, lrun, bq, N, Mk, qpos, vimg, lane);
    }
    attn_store(o, lrun, (bf16*)(A.ws + WS_YC) + m * EVEN_OUT + 2048 + hh * 128, lane, c < 8);
}
DI void ph_mem_attn(const Args& A, Frame& F, int li) {
    const int lane = F.lane, c = lane & 15; LAS unsigned char* vimg = F.lds + RING_OFF + F.wave * VIMG_BYTES;
    const bf16* qm = (const bf16*)(A.ws + WS_QM); bf16* om = (bf16*)(A.ws + WS_OM);
    MaskP Mk; Mk.dmask = 0; Mk.dshift = 0; Mk.win = 0; Mk.bias = nullptr; Mk.nomask = 1;
    const int NS = DB * 4, NPT = NB * (SEQ / 16) * 4;
    for (int t = gwave(F); t < NS + NPT; t += ngwave(F)) {
        f32x4 o[8];
#pragma unroll
        for (int i = 0; i < 8; ++i) o[i] = (f32x4){0.f, 0.f, 0.f, 0.f};
        float mrun = -INFINITY, lrun = 0.f; bf16x8 bq[4];
        if (t < NS) { const int b = t >> 2, mh = t & 3; const size_t m = (size_t)TP + b * DSEQ + (c & 7);
            attn_load_q(bq, qm + m * MEM_W + mh * 128, A.in[I_MQN] + li * 128, 0.08838834764831845f * LOG2E, lane);
            KeyEnum E; E.kbase = (const char*)(A.in[I_CMEM] + ((size_t)(li * DB + b) * MEMT) * 1024 + mh * 128); E.stride = 1024 * 4; E.voff = 512 * 4; E.p0 = 0; E.sh = 0; E.a = 1; E.pbase = 0; E.nk = MEMT;
            attn_keys<true>(o, mrun, lrun, bq, E, Mk, 0, vimg, lane);
            attn_store(o, lrun, om + m * MEM_W + mh * 128, lane, c < 8);
        } else { const int u = t - NS, mh = u & 3, tt = (u >> 2) % (SEQ / 16), b = u / (4 * (SEQ / 16)); const size_t m = (size_t)b * SEQ + 16 * tt + c;
            attn_load_q(bq, qm + m * MEM_W + mh * 128, A.in[I_MQN] + li * 128, 0.08838834764831845f * LOG2E, lane);
            KeyEnum E; E.kbase = (const char*)((const bf16*)(A.ws + WS_KVP) + ((size_t)(li * NB + b) * MEMT) * 1024 + mh * 128); E.stride = 1024 * 2; E.voff = 512 * 2; E.p0 = 0; E.sh = 0; E.a = 1; E.pbase = 0; E.nk = MEMT;
            attn_keys<false>(o, mrun, lrun, bq, E, Mk, 0, vimg, lane);
            attn_store(o, lrun, om + m * MEM_W + mh * 128, lane, true);
        }
    }
}
constexpr int RL_Q = 0, RL_K = 17408, RL_V = 34816, RL_P = 68608, RL_G = 77824, RL_ST = 111616, RL_MR = 115712;
DI void ret_prompt_unit(const Args& A, Frame& F, int b, int h) {
    LAS unsigned char* L = F.lds + RING_OFF;
    LAS bf16* QI = (LAS bf16*)(L + RL_Q); LAS bf16* KI = (LAS bf16*)(L + RL_K); LAS bf16* VI = (LAS bf16*)(L + RL_V); LAS bf16* PI = (LAS bf16*)(L + RL_P); LAS bf16* GI = (LAS bf16*)(L + RL_G);
    LAS float* ST = (LAS float*)(L + RL_ST); LAS float* MR = (LAS float*)(L + RL_MR);
    const int tid = F.tid, lane = F.lane, w = F.wave, c = lane & 15, g = lane >> 4, rr = tid >> 3, sub = tid & 7;
    const float lg = log1pf(-exp2f(-5.f - (float)h));
    const float qs = 0.08838834764831845f * __expf((float)(rr - 63) * lg), ksc = __expf((float)(63 - rr) * lg), g64 = __expf(64.f * lg);
    const bf16* proj = (const bf16*)(A.ws + WS_PROJ); const size_t row0 = (size_t)b * SEQ;
    const f32x4* rope = (const f32x4*)(A.ws + WS_ROPE);
    const float gw0 = A.in[I_GNW][h * 256 + 32 * w + c], gw1 = A.in[I_GNW][h * 256 + 32 * w + 16 + c];
    f32x4 S[8][2];
#pragma unroll
    for (int i = 0; i < 8; ++i) { S[i][0] = (f32x4){0.f, 0.f, 0.f, 0.f}; S[i][1] = (f32x4){0.f, 0.f, 0.f, 0.f}; }
    v4u rq[2], rk[2]; f32x4 rc[4];
#define RET_LOAD(n) do { const bf16* rp = proj + (row0 + 64 * (n) + rr) * EVEN_IN; \
        rq[0] = *(const GAS v4u*)(rp + C_QR + h * 128 + 8 * sub); rq[1] = *(const GAS v4u*)(rp + C_QR + h * 128 + 64 + 8 * sub); \
        rk[0] = *(const GAS v4u*)(rp + C_KR + h * 128 + 8 * sub); rk[1] = *(const GAS v4u*)(rp + C_KR + h * 128 + 64 + 8 * sub); \
        _Pragma("unroll") for (int jj = 0; jj < 4; ++jj) rc[jj] = rope[((64 * (n) + rr) * 64 + 8 * sub) / 2 + jj]; } while (0)
    RET_LOAD(0);
    for (int n = 0; n < SEQ / 64; ++n) {
        { float q1[8], q2[8], k1[8], k2[8], cs[8], sn[8];
          q1[0] = bflo(rq[0].x); q1[1] = bfhi(rq[0].x); q1[2] = bflo(rq[0].y); q1[3] = bfhi(rq[0].y); q1[4] = bflo(rq[0].z); q1[5] = bfhi(rq[0].z); q1[6] = bflo(rq[0].w); q1[7] = bfhi(rq[0].w);
          q2[0] = bflo(rq[1].x); q2[1] = bfhi(rq[1].x); q2[2] = bflo(rq[1].y); q2[3] = bfhi(rq[1].y); q2[4] = bflo(rq[1].z); q2[5] = bfhi(rq[1].z); q2[6] = bflo(rq[1].w); q2[7] = bfhi(rq[1].w);
          k1[0] = bflo(rk[0].x); k1[1] = bfhi(rk[0].x); k1[2] = bflo(rk[0].y); k1[3] = bfhi(rk[0].y); k1[4] = bflo(rk[0].z); k1[5] = bfhi(rk[0].z); k1[6] = bflo(rk[0].w); k1[7] = bfhi(rk[0].w);
          k2[0] = bflo(rk[1].x); k2[1] = bfhi(rk[1].x); k2[2] = bflo(rk[1].y); k2[3] = bfhi(rk[1].y); k2[4] = bflo(rk[1].z); k2[5] = bfhi(rk[1].z); k2[6] = bflo(rk[1].w); k2[7] = bfhi(rk[1].w);
#pragma unroll
          for (int jj = 0; jj < 4; ++jj) { cs[2 * jj] = rc[jj].x; sn[2 * jj] = rc[jj].y; cs[2 * jj + 1] = rc[jj].z; sn[2 * jj + 1] = rc[jj].w; }
          float a1[8], a2[8], b1[8], b2[8];
#pragma unroll
          for (int j = 0; j < 8; ++j) { a1[j] = (q1[j] * cs[j] - q2[j] * sn[j]) * qs; a2[j] = (q1[j] * sn[j] + q2[j] * cs[j]) * qs; b1[j] = (k1[j] * cs[j] - k2[j] * sn[j]) * ksc; b2[j] = (k1[j] * sn[j] + k2[j] * cs[j]) * ksc; }
          v4u t;
          t.x = pk2(a1[0], a1[1]); t.y = pk2(a1[2], a1[3]); t.z = pk2(a1[4], a1[5]); t.w = pk2(a1[6], a1[7]); *(LAS v4u*)(QI + rr * 136 + 8 * sub) = t;
          t.x = pk2(a2[0], a2[1]); t.y = pk2(a2[2], a2[3]); t.z = pk2(a2[4], a2[5]); t.w = pk2(a2[6], a2[7]); *(LAS v4u*)(QI + rr * 136 + 64 + 8 * sub) = t;
          t.x = pk2(b1[0], b1[1]); t.y = pk2(b1[2], b1[3]); t.z = pk2(b1[4], b1[5]); t.w = pk2(b1[6], b1[7]); *(LAS v4u*)(KI + rr * 136 + 8 * sub) = t;
          t.x = pk2(b2[0], b2[1]); t.y = pk2(b2[2], b2[3]); t.z = pk2(b2[4], b2[5]); t.w = pk2(b2[6], b2[7]); *(LAS v4u*)(KI + rr * 136 + 64 + 8 * sub) = t;
 }
        __syncthreads();
        v4u rv[4];
        { const bf16* rp = proj + (row0 + 64 * n + rr) * EVEN_IN + C_VR + h * 256 + 8 * sub;
#pragma unroll
          for (int jj = 0; jj < 4; ++jj) rv[jj] = *(const GAS v4u*)(rp + 64 * jj); }
        if (n + 1 < SEQ / 64) RET_LOAD(n + 1);
        { const int it = w >> 1;
#pragma unroll
          for (int q = 0; q < 2; ++q) { const int jt = 2 * (w & 1) + q; f32x4 s = (f32x4){0.f, 0.f, 0.f, 0.f};
#pragma unroll
              for (int ks = 0; ks < 4; ++ks) { const bf16x8 ka = *(const LAS bf16x8*)(KI + (16 * jt + c) * 136 + 32 * ks + 8 * g), qb = *(const LAS bf16x8*)(QI + (16 * it + c) * 136 + 32 * ks + 8 * g); s = MFMA16(ka, qb, s); }
              const int i = 16 * it + c, j0 = 16 * jt + 4 * g; v2u pw; pw.x = pk2(i >= j0 ? s.x : 0.f, i >= j0 + 1 ? s.y : 0.f); pw.y = pk2(i >= j0 + 2 ? s.z : 0.f, i >= j0 + 3 ? s.w : 0.f);
              *(LAS v2u*)(PI + i * 72 + j0) = pw; } }
#pragma unroll
        for (int i = 0; i < 8; ++i) { S[i][0] *= g64; S[i][1] *= g64; }
#pragma unroll
        for (int jj = 0; jj < 4; ++jj) *(LAS v4u*)(VI + rr * 264 + 64 * jj + 8 * sub) = rv[jj];
        __syncthreads();
        bf16x8 vb[2][2];
#pragma unroll
        for (int ks = 0; ks < 2; ++ks)
#pragma unroll
            for (int et = 0; et < 2; ++et) { const LAS unsigned char* p = (const LAS unsigned char*)(VI + (32 * ks + 8 * g + (c >> 2)) * 264 + 32 * w + 16 * et + 4 * (c & 3)); vb[ks][et] = cat4(tr16(p), tr16(p + 4 * 264 * 2)); }
        f32x4 O[4][2];
#pragma unroll
        for (int it = 0; it < 4; ++it) { O[it][0] = (f32x4){0.f, 0.f, 0.f, 0.f}; O[it][1] = (f32x4){0.f, 0.f, 0.f, 0.f};
#pragma unroll
            for (int ks = 0; ks < 2; ++ks) { const bf16x8 pa = *(const LAS bf16x8*)(PI + (16 * it + c) * 72 + 32 * ks + 8 * g); O[it][0] = MFMA16(pa, vb[ks][0], O[it][0]); O[it][1] = MFMA16(pa, vb[ks][1], O[it][1]); } }
#pragma unroll
        for (int dk = 0; dk < 4; ++dk) { bf16x8 qa[4];
#pragma unroll
            for (int it = 0; it < 4; ++it) { const s16x4 q0 = *(const LAS s16x4*)(QI + (16 * it + c) * 136 + 32 * dk + 4 * g), q1 = *(const LAS s16x4*)(QI + (16 * it + c) * 136 + 32 * dk + 16 + 4 * g); qa[it] = cat4(q0, q1); }
#pragma unroll
            for (int et = 0; et < 2; ++et) { const bf16x8 sbf = cvt8(S[2 * dk][et], S[2 * dk + 1][et]);
#pragma unroll
                for (int it = 0; it < 4; ++it) O[it][et] = MFMA16(qa[it], sbf, O[it][et]); } }
#pragma unroll
        for (int dt = 0; dt < 8; ++dt)
#pragma unroll
            for (int ks = 0; ks < 2; ++ks) { const LAS unsigned char* p = (const LAS unsigned char*)(KI + (32 * ks + 8 * g + (c >> 2)) * 136 + 16 * dt + 4 * (c & 3)); const bf16x8 ka = cat4(tr16(p), tr16(p + 4 * 136 * 2));
                S[dt][0] = MFMA16(ka, vb[ks][0], S[dt][0]); S[dt][1] = MFMA16(ka, vb[ks][1], S[dt][1]); }
        v4u rg[4];
        { const bf16* rp = proj + (row0 + 64 * n + rr) * EVEN_IN + C_GR + h * 256 + 8 * sub;
#pragma unroll
          for (int jj = 0; jj < 4; ++jj) rg[jj] = *(const GAS v4u*)(rp + 64 * jj); }
#pragma unroll
        for (int it = 0; it < 4; ++it)
#pragma unroll
            for (int r = 0; r < 4; ++r) { float s1 = O[it][0][r] + O[it][1][r], s2 = O[it][0][r] * O[it][0][r] + O[it][1][r] * O[it][1][r];
#pragma unroll
                for (int x = 1; x < 16; x <<= 1) { s1 += __shfl_xor(s1, x); s2 += __shfl_xor(s2, x); }
                if (c == 0) { const int i = 16 * it + 4 * g + r; ST[(i * 8 + w) * 2] = s1; ST[(i * 8 + w) * 2 + 1] = s2; } }
#pragma unroll
        for (int jj = 0; jj < 4; ++jj) *(LAS v4u*)(GI + rr * 264 + 64 * jj + 8 * sub) = rg[jj];
        __syncthreads();
        if (tid < 64) { float s1 = 0.f, s2 = 0.f;
#pragma unroll
            for (int x = 0; x < 8; ++x) { s1 += ST[(tid * 8 + x) * 2]; s2 += ST[(tid * 8 + x) * 2 + 1]; }
            const float mu = s1 * (1.f / 256.f), var = fmaxf(s2 * (1.f / 256.f) - mu * mu, 0.f); MR[2 * tid] = mu; MR[2 * tid + 1] = rsqrtf(var + EPS); }
        __syncthreads();
#pragma unroll
        for (int it = 0; it < 4; ++it)
#pragma unroll
            for (int r = 0; r < 4; ++r) { const int i = 16 * it + 4 * g + r; const float mu = MR[2 * i], rs = MR[2 * i + 1];
#pragma unroll
                for (int et = 0; et < 2; ++et) { LAS bf16* gp = GI + i * 264 + 32 * w + 16 * et + c; const float gt = bf2f(*gp);
                    const float y = (O[it][et][r] - mu) * rs * (et ? gw1 : gw0) * silu(gt); *gp = (bf16)f2bf(y); } }
        __syncthreads();
        { bf16* yp = (bf16*)(A.ws + WS_YC) + (row0 + 64 * n + rr) * EVEN_OUT + h * 256;
#pragma unroll
          for (int jj = 0; jj < 4; ++jj) *(GAS v4u*)(yp + 64 * jj + 8 * sub) = *(const LAS v4u*)(GI + rr * 264 + 64 * jj + 8 * sub); }
    }
#undef RET_LOAD
    { float* sp = A.out + O_RETP + ((size_t)(b * 8 + h) * 128) * 256;
#pragma unroll
      for (int dt = 0; dt < 8; ++dt)
#pragma unroll
          for (int et = 0; et < 2; ++et)
#pragma unroll
              for (int r = 0; r < 4; ++r) sp[(size_t)(16 * dt + 4 * g + r) * 256 + 32 * w + 16 * et + c] = S[dt][et][r]; }
    __syncthreads();
}
DI void ret_sample_unit(const Args& A, Frame& F, int b, int h) {
    __syncthreads();
    LAS float* qT = (LAS float*)(F.lds + RING_OFF);
    LAS float* kT = qT + 1024;
    LAS float* SC = kT + 1024;
    LAS float* PT = SC + 64;
    LAS float* ST = PT + 4096;
    const int tid = F.tid, lane = F.lane, w = F.wave, e = tid & 255, dh = tid >> 8;
    const float lg = log1pf(-exp2f(-5.f - (float)h));
    const bf16* proj = (const bf16*)(A.ws + WS_PROJ); const size_t m0 = (size_t)TP + b * DSEQ;
    { const int row = tid >> 6, i = tid & 63; const bf16* rp = proj + (m0 + row) * EVEN_IN;
      const f32x2 cs = ((const f32x2*)(A.ws + WS_ROPE))[(SEQ + row) * 64 + i];
      const float q1 = bf2f(rp[C_QR + h * 128 + i]), q2 = bf2f(rp[C_QR + h * 128 + 64 + i]), k1 = bf2f(rp[C_KR + h * 128 + i]), k2 = bf2f(rp[C_KR + h * 128 + 64 + i]);
      const float ksc = __expf((float)(7 - row) * lg);
      qT[i * 8 + row] = (q1 * cs.x - q2 * cs.y) * 0.08838834764831845f; qT[(i + 64) * 8 + row] = (q1 * cs.y + q2 * cs.x) * 0.08838834764831845f;
      kT[i * 8 + row] = (k1 * cs.x - k2 * cs.y) * ksc; kT[(i + 64) * 8 + row] = (k1 * cs.y + k2 * cs.x) * ksc; }
    float vv[8];
#pragma unroll
    for (int j = 0; j < 8; ++j) vv[j] = bf2f(proj[(m0 + j) * EVEN_IN + C_VR + h * 256 + e]);
    __syncthreads();
    if (tid < 64) { const int i = tid >> 3, j = tid & 7; float s = 0.f;
        for (int d = 0; d < 128; ++d) s += qT[d * 8 + i] * kT[d * 8 + j];
        SC[tid] = j <= i ? s * __expf((float)(i - 7) * lg) : 0.f; }
    const float g8 = __expf(8.f * lg);
    float acc[8];
#pragma unroll
    for (int i = 0; i < 8; ++i) acc[i] = 0.f;
    const float* s0p = A.in[I_SRET] + ((size_t)(b * 8 + h) * 128 + 64 * dh) * 256 + e; float* s1p = A.out + O_RETS + ((size_t)(b * 8 + h) * 128 + 64 * dh) * 256 + e;
#pragma unroll 4
    for (int dd = 0; dd < 64; ++dd) { const int d = 64 * dh + dd; const float s0 = s0p[(size_t)dd * 256];
        const f32x4 qa = *(const LAS f32x4*)(qT + d * 8), qb = *(const LAS f32x4*)(qT + d * 8 + 4), ka = *(const LAS f32x4*)(kT + d * 8), kb = *(const LAS f32x4*)(kT + d * 8 + 4);
        acc[0] += qa.x * s0; acc[1] += qa.y * s0; acc[2] += qa.z * s0; acc[3] += qa.w * s0; acc[4] += qb.x * s0; acc[5] += qb.y * s0; acc[6] += qb.z * s0; acc[7] += qb.w * s0;
        float sf = g8 * s0; sf += ka.x * vv[0]; sf += ka.y * vv[1]; sf += ka.z * vv[2]; sf += ka.w * vv[3]; sf += kb.x * vv[4]; sf += kb.y * vv[5]; sf += kb.z * vv[6]; sf += kb.w * vv[7];
        s1p[(size_t)dd * 256] = sf; }
#pragma unroll
    for (int i = 0; i < 8; ++i) PT[(dh * 8 + i) * 256 + e] = acc[i];
    __syncthreads();
    float o[4];
#pragma unroll
    for (int ii = 0; ii < 4; ++ii) { const int i = 4 * dh + ii; float x = (PT[i * 256 + e] + PT[(8 + i) * 256 + e]) * __expf((float)(i + 1) * lg);
#pragma unroll
        for (int j = 0; j < 8; ++j) x += SC[i * 8 + j] * vv[j];
        o[ii] = x; const float s1 = wave_sum(x), s2 = wave_sum(x * x);
        if (lane == 0) { ST[(i * 4 + (w & 3)) * 2] = s1; ST[(i * 4 + (w & 3)) * 2 + 1] = s2; } }
    __syncthreads();
    const float gnw = A.in[I_GNW][h * 256 + e];
#pragma unroll
    for (int ii = 0; ii < 4; ++ii) { const int i = 4 * dh + ii; float s1 = 0.f, s2 = 0.f;
#pragma unroll
        for (int x = 0; x < 4; ++x) { s1 += ST[(i * 4 + x) * 2]; s2 += ST[(i * 4 + x) * 2 + 1]; }
        const float mu = s1 * (1.f / 256.f), var = fmaxf(s2 * (1.f / 256.f) - mu * mu, 0.f), rs = rsqrtf(var + EPS);
        const float gt = bf2f(proj[(m0 + i) * EVEN_IN + C_GR + h * 256 + e]);
        ((bf16*)(A.ws + WS_YC))[(m0 + i) * EVEN_OUT + h * 256 + e] = (bf16)f2bf((o[ii] - mu) * rs * gnw * silu(gt)); }
    __syncthreads();
}
DI void ph_mix_even(const Args& A, Frame& F) {
    LAS unsigned char* vimg = F.lds + RING_OFF + F.wave * VIMG_BYTES;
    const int NRP = NB * 8;
    if (F.bx < NRP) { ret_prompt_unit(A, F, F.bx >> 3, F.bx & 7); return; }
    const int nw = F.G - NRP;
    for (int u = F.bx - NRP; u < 256 + 32 + 256; u += nw) {
        if (u < 256) { const int b = u >> 6, hh = (u >> 3) & 7, blk = u & 7;
            swa_prompt_tile(A, F, b, hh, blk, F.wave, vimg); swa_prompt_tile(A, F, b, hh, blk, F.wave + 8, vimg); }
        else if (u < 288) { const int t = (u - 256) * 8 + F.wave; swa_sample_tile(A, F, t >> 3, t & 7, vimg); }
        else { const int t = u - 288; ret_sample_unit(A, F, t >> 3, t & 7); }
    }
}
DI void ph_gdn_pre(const Args& A, Frame& F) {
    const int lane = F.lane; const bf16* pj = (const bf16*)(A.ws + WS_PROJ);
    for (int it = gwave(F); it < MT * 9; it += ngwave(F)) {
        const int m = it / 9, cg = it % 9;
        if (cg == 8) { if (lane < 32) { const float bi = bf2f(pj[(size_t)m * ODD_INP + C_BETA + lane]), ai = bf2f(pj[(size_t)m * ODD_INP + C_AIN + lane]) + A.in[I_DTB][lane];
                const float sp = ai > 20.f ? ai : log1pf(__expf(ai));
                ((float*)(A.ws + WS_GB))[(size_t)m * 32 + lane] = 1.f / (1.f + __expf(-bi)); ((float*)(A.ws + WS_GG))[(size_t)m * 32 + lane] = -__expf(A.in[I_ALOG][lane]) * sp; }
            continue; }
        const int ch = 1024 * cg + 16 * lane;
        const bool prm = m < TP; const int b = prm ? m / SEQ : (m - TP) / DSEQ, t = prm ? m % SEQ : (m - TP) % DSEQ; const size_t mb = prm ? (size_t)b * SEQ : (size_t)TP + b * DSEQ;
        float y[16], xr[16];
#pragma unroll
        for (int j = 0; j < 16; ++j) y[j] = 0.f;
#pragma unroll
        for (int j = 0; j < 4; ++j) { const int tt = t - 3 + j; float x[16];
            if (tt >= 0) { const bf16* p = pj + (mb + tt) * ODD_INP + ch; unpack16(*(const GAS v4u*)p, *(const GAS v4u*)(p + 8), x); }
            else if (!prm) { const float* p = A.in[I_SCONV] + ((size_t)b * 3 + (tt + 3)) * CONV_CH + ch;
#pragma unroll
                for (int q = 0; q < 4; ++q) { const f32x4 v = *(const GAS f32x4*)(p + 4 * q); x[4 * q] = v.x; x[4 * q + 1] = v.y; x[4 * q + 2] = v.z; x[4 * q + 3] = v.w; } }
            else {
#pragma unroll
                for (int q = 0; q < 16; ++q) x[q] = 0.f; }
            const float* wp = A.in[I_CONVW] + (size_t)j * CONV_CH + ch;
#pragma unroll
            for (int q = 0; q < 4; ++q) { const f32x4 wv = *(const GAS f32x4*)(wp + 4 * q); y[4 * q] += wv.x * x[4 * q]; y[4 * q + 1] += wv.y * x[4 * q + 1]; y[4 * q + 2] += wv.z * x[4 * q + 2]; y[4 * q + 3] += wv.w * x[4 * q + 3]; }
            if (j == 3) {
#pragma unroll
                for (int q = 0; q < 16; ++q) xr[q] = x[q]; } }
        { float* dst = nullptr;
          if (prm) { if (t >= SEQ - 3) dst = A.out + O_CONVP + ((size_t)b * 3 + (t - (SEQ - 3))) * CONV_CH + ch; } else { if (t >= DSEQ - 3) dst = A.out + O_CONVS + ((size_t)b * 3 + (t - (DSEQ - 3))) * CONV_CH + ch; }
          if (dst) {
#pragma unroll
              for (int q = 0; q < 4; ++q) *(GAS f32x4*)(dst + 4 * q) = (f32x4){xr[4 * q], xr[4 * q + 1], xr[4 * q + 2], xr[4 * q + 3]}; } }
        float ss = 0.f;
#pragma unroll
        for (int j = 0; j < 16; ++j) { y[j] = silu(y[j]); ss += y[j] * y[j]; }
        ss += __shfl_xor(ss, 1); ss += __shfl_xor(ss, 2); ss += __shfl_xor(ss, 4);
        const float sc = cg < 4 ? rsqrtf(ss + EPS) : 1.f;
        v4u o0, o1; o0.x = pk2(y[0] * sc, y[1] * sc); o0.y = pk2(y[2] * sc, y[3] * sc); o0.z = pk2(y[4] * sc, y[5] * sc); o0.w = pk2(y[6] * sc, y[7] * sc);
        o1.x = pk2(y[8] * sc, y[9] * sc); o1.y = pk2(y[10] * sc, y[11] * sc); o1.z = pk2(y[12] * sc, y[13] * sc); o1.w = pk2(y[14] * sc, y[15] * sc);
        bf16* dst = cg < 2 ? (bf16*)(A.ws + WS_QN) + (size_t)m * 2048 + ch : cg < 4 ? (bf16*)(A.ws + WS_KN) + (size_t)m * 2048 + (ch - 2048) : (bf16*)(A.ws + WS_VV) + (size_t)m * 4096 + (ch - 4096);
        *(GAS v4u*)dst = o0; *(GAS v4u*)(dst + 8) = o1;
    }
}
template <int R, int SB> DI void fs_blocks(float& acc, const float (&x)[64], const LAS float* AM) {
    if constexpr (4 * SB < R) { const f32x4 a = *(const LAS f32x4*)(AM + R * 68 + 4 * SB);
        acc -= a.x * x[4 * SB]; if constexpr (4 * SB + 1 < R) acc -= a.y * x[4 * SB + 1]; if constexpr (4 * SB + 2 < R) acc -= a.z * x[4 * SB + 2]; if constexpr (4 * SB + 3 < R) acc -= a.w * x[4 * SB + 3];
        fs_blocks<R, SB + 1>(acc, x, AM); }
}
template <int R> DI void fs_rows(float (&x)[64], const LAS float* AM, const LAS float* BM, int col) {
    if constexpr (R < 64) { float acc = BM[R * 260 + col]; fs_blocks<R, 0>(acc, x, AM); x[R] = acc; fs_rows<R + 1>(x, AM, BM, col); }
}
constexpr int GP_K = 0, GP_Q = 17408, GP_A = 34816, GP_B = 52224, GP_G = 118784;
DI void gdn_prep_unit(const Args& A, Frame& F, int b, int h, int n) {
    LAS unsigned char* L = F.lds + RING_OFF;
    LAS bf16* KI = (LAS bf16*)(L + GP_K); LAS bf16* QI = (LAS bf16*)(L + GP_Q); LAS float* AM = (LAS float*)(L + GP_A); LAS float* BM = (LAS float*)(L + GP_B); LAS float* GCs = (LAS float*)(L + GP_G); LAS float* BTs = GCs + 64;
    const int tid = F.tid, lane = F.lane, w = F.wave, c = lane & 15, g = lane >> 4, rr = tid >> 3, sub = tid & 7;
    const size_t m0 = (size_t)b * SEQ + 64 * n;
    const bf16* kp = (const bf16*)(A.ws + WS_KN) + (m0 + rr) * 2048 + (h >> 1) * 128 + 16 * sub; const bf16* qp = (const bf16*)(A.ws + WS_QN) + (m0 + rr) * 2048 + (h >> 1) * 128 + 16 * sub;
    const bf16* vp = (const bf16*)(A.ws + WS_VV) + (m0 + rr) * 4096 + h * 128 + 16 * sub;
    const v4u k0 = *(const GAS v4u*)kp, k1 = *(const GAS v4u*)(kp + 8), q0 = *(const GAS v4u*)qp, q1 = *(const GAS v4u*)(qp + 8), v0 = *(const GAS v4u*)vp, v1 = *(const GAS v4u*)(vp + 8);
    if (tid < 64) { float x = ((const float*)(A.ws + WS_GG))[(m0 + tid) * 32 + h];
#pragma unroll
        for (int o = 1; o < 64; o <<= 1) { const float y = __shfl_up(x, o); if (lane >= o) x += y; }
        GCs[tid] = x; BTs[tid] = ((const float*)(A.ws + WS_GB))[(m0 + tid) * 32 + h]; ((float*)(A.ws + WS_GC))[(m0 + tid) * 32 + h] = x; }
    __syncthreads();
    { const float bt = BTs[rr], eg = __expf(GCs[rr]); float kf[16], vf[16]; unpack16(k0, k1, kf); unpack16(v0, v1, vf);
      *(LAS v4u*)(KI + rr * 136 + 16 * sub) = k0; *(LAS v4u*)(KI + rr * 136 + 16 * sub + 8) = k1; *(LAS v4u*)(QI + rr * 136 + 16 * sub) = q0; *(LAS v4u*)(QI + rr * 136 + 16 * sub + 8) = q1;
#pragma unroll
      for (int q = 0; q < 4; ++q) { *(LAS f32x4*)(BM + rr * 260 + 16 * sub + 4 * q) = (f32x4){vf[4 * q] * bt, vf[4 * q + 1] * bt, vf[4 * q + 2] * bt, vf[4 * q + 3] * bt};
          *(LAS f32x4*)(BM + rr * 260 + 128 + 16 * sub + 4 * q) = (f32x4){kf[4 * q] * bt * eg, kf[4 * q + 1] * bt * eg, kf[4 * q + 2] * bt * eg, kf[4 * q + 3] * bt * eg}; } }
    __syncthreads();
    { const int it = w >> 1; bf16* attn = (bf16*)(A.ws + WS_ATT) + ((size_t)(b * 32 + h) * 32 + n) * 4096;
      const int ci = 16 * it + c; const float gcc = GCs[ci], btc = BTs[ci];
#pragma unroll
      for (int q = 0; q < 2; ++q) { const int jt = 2 * (w & 1) + q; const int s0 = 16 * jt + 4 * g;
          f32x4 kk = (f32x4){0.f, 0.f, 0.f, 0.f}, qk = (f32x4){0.f, 0.f, 0.f, 0.f};
          if (jt <= it) {
#pragma unroll
              for (int ks = 0; ks < 4; ++ks) { const bf16x8 a = *(const LAS bf16x8*)(KI + (16 * jt + c) * 136 + 32 * ks + 8 * g), bk = *(const LAS bf16x8*)(KI + ci * 136 + 32 * ks + 8 * g), bq = *(const LAS bf16x8*)(QI + ci * 136 + 32 * ks + 8 * g);
                  kk = MFMA16(a, bk, kk); qk = MFMA16(a, bq, qk); } }
          const f32x4 gs = *(const LAS f32x4*)(GCs + s0);
          f32x4 am, at;
#pragma unroll
          for (int r = 0; r < 4; ++r) { const int s = s0 + r; const float dc = __expf(fminf(gcc - gs[r], 0.f)); am[r] = s < ci ? btc * kk[r] * dc : 0.f; at[r] = s <= ci ? qk[r] * 0.08838834764831845f * dc : 0.f; }
          *(LAS f32x4*)(AM + ci * 68 + s0) = am;
          v2u pw; pw.x = pk2(at[0], at[1]); pw.y = pk2(at[2], at[3]); *(GAS v2u*)(attn + ci * 64 + s0) = pw; } }
    __syncthreads();
    if (w < 4) { const int col = 64 * w + lane; float x[64];
        fs_rows<0>(x, AM, BM, col);
        bf16* dst = (bf16*)(A.ws + (w < 2 ? WS_UC : WS_WC)) + (m0 * 32 + h) * 128 + (col & 127);
#pragma unroll
        for (int r = 0; r < 64; ++r) dst[(size_t)r * 4096] = (bf16)f2bf(x[r]); }
    __syncthreads();
}
DI void ph_gdn_prep(const Args& A, Frame& F) {
    for (int u = F.bx; u < NB * 32 * 32; u += F.G) gdn_prep_unit(A, F, u >> 10, (u >> 5) & 31, u & 31);
}
constexpr int GS_W = 0, GS_U = 17408, GS_Q = 34816, GS_K = 52224, GS_A = 69632, GS_ST = 78848, GS_MR = 80896, GS_Z = 81152;
DI void gdn_scan_unit(const Args& A, Frame& F, int b, int h) {
    LAS unsigned char* L = F.lds + RING_OFF;
    LAS bf16* WI = (LAS bf16*)(L + GS_W); LAS bf16* UI = (LAS bf16*)(L + GS_U); LAS bf16* QG = (LAS bf16*)(L + GS_Q); LAS bf16* KD = (LAS bf16*)(L + GS_K); LAS bf16* AI = (LAS bf16*)(L + GS_A);
    LAS float* ST = (LAS float*)(L + GS_ST); LAS float* MR = (LAS float*)(L + GS_MR); LAS bf16* ZI = (LAS bf16*)(L + GS_Z);
    const int tid = F.tid, lane = F.lane, w = F.wave, c = lane & 15, g = lane >> 4, rr = tid >> 3, sub = tid & 7;
    const size_t row0 = (size_t)b * SEQ;
    const bf16* UCp = (const bf16*)(A.ws + WS_UC); const bf16* WCp = (const bf16*)(A.ws + WS_WC); const bf16* QNp = (const bf16*)(A.ws + WS_QN); const bf16* KNp = (const bf16*)(A.ws + WS_KN);
    const bf16* PJ = (const bf16*)(A.ws + WS_PROJ); const float* GCp = (const float*)(A.ws + WS_GC);
    const float nw = A.in[I_GDNNW][16 * w + c];
    f32x4 S[8];
#pragma unroll
    for (int i = 0; i < 8; ++i) S[i] = (f32x4){0.f, 0.f, 0.f, 0.f};
    v4u rw[2], ru[2], rq[2], rk[2], ra; float rgc, rgl;
#define GS_LOAD(n) do { const size_t m = row0 + 64 * (n) + rr; \
        const bf16* p = WCp + (m * 32 + h) * 128 + 16 * sub; rw[0] = *(const GAS v4u*)p; rw[1] = *(const GAS v4u*)(p + 8); \
        p = UCp + (m * 32 + h) * 128 + 16 * sub; ru[0] = *(const GAS v4u*)p; ru[1] = *(const GAS v4u*)(p + 8); \
        p = QNp + m * 2048 + (h >> 1) * 128 + 16 * sub; rq[0] = *(const GAS v4u*)p; rq[1] = *(const GAS v4u*)(p + 8); \
        p = KNp + m * 2048 + (h >> 1) * 128 + 16 * sub; rk[0] = *(const GAS v4u*)p; rk[1] = *(const GAS v4u*)(p + 8); \
        ra = *(const GAS v4u*)((const bf16*)(A.ws + WS_ATT) + ((size_t)(b * 32 + h) * 32 + (n)) * 4096 + rr * 64 + 8 * sub); \
        rgc = GCp[m * 32 + h]; rgl = GCp[(row0 + 64 * (n) + 63) * 32 + h]; } while (0)
    GS_LOAD(0);
    for (int n = 0; n < SEQ / 64; ++n) {
        { float x[16]; v4u t0, t1;
          *(LAS v4u*)(WI + rr * 136 + 16 * sub) = rw[0]; *(LAS v4u*)(WI + rr * 136 + 16 * sub + 8) = rw[1]; *(LAS v4u*)(UI + rr * 136 + 16 * sub) = ru[0]; *(LAS v4u*)(UI + rr * 136 + 16 * sub + 8) = ru[1];
          const float sq = 0.08838834764831845f * __expf(rgc), sk = __expf(rgl - rgc);
          unpack16(rq[0], rq[1], x);
          t0.x = pk2(x[0] * sq, x[1] * sq); t0.y = pk2(x[2] * sq, x[3] * sq); t0.z = pk2(x[4] * sq, x[5] * sq); t0.w = pk2(x[6] * sq, x[7] * sq); t1.x = pk2(x[8] * sq, x[9] * sq); t1.y = pk2(x[10] * sq, x[11] * sq); t1.z = pk2(x[12] * sq, x[13] * sq); t1.w = pk2(x[14] * sq, x[15] * sq);
          *(LAS v4u*)(QG + rr * 136 + 16 * sub) = t0; *(LAS v4u*)(QG + rr * 136 + 16 * sub + 8) = t1;
          unpack16(rk[0], rk[1], x);
          t0.x = pk2(x[0] * sk, x[1] * sk); t0.y = pk2(x[2] * sk, x[3] * sk); t0.z = pk2(x[4] * sk, x[5] * sk); t0.w = pk2(x[6] * sk, x[7] * sk); t1.x = pk2(x[8] * sk, x[9] * sk); t1.y = pk2(x[10] * sk, x[11] * sk); t1.z = pk2(x[12] * sk, x[13] * sk); t1.w = pk2(x[14] * sk, x[15] * sk);
          *(LAS v4u*)(KD + rr * 136 + 16 * sub) = t0; *(LAS v4u*)(KD + rr * 136 + 16 * sub + 8) = t1;
          *(LAS v4u*)(AI + rr * 72 + 8 * sub) = ra; }
        const float egl = __expf(rgl);
        __syncthreads();
        v4u rz[2];
        { const bf16* p = PJ + (row0 + 64 * n + rr) * ODD_INP + C_Z + h * 128 + 16 * sub; rz[0] = *(const GAS v4u*)p; rz[1] = *(const GAS v4u*)(p + 8); }
        if (n + 1 < SEQ / 64) GS_LOAD(n + 1);
        bf16x8 sb[4];
#pragma unroll
        for (int dk = 0; dk < 4; ++dk) sb[dk] = cvt8(S[2 * dk], S[2 * dk + 1]);
        f32x4 vn[4];
#pragma unroll
        for (int it = 0; it < 4; ++it) { f32x4 ws = (f32x4){0.f, 0.f, 0.f, 0.f};
#pragma unroll
            for (int dk = 0; dk < 4; ++dk) { const bf16x8 wa = cat4(*(const LAS s16x4*)(WI + (16 * it + c) * 136 + 32 * dk + 4 * g), *(const LAS s16x4*)(WI + (16 * it + c) * 136 + 32 * dk + 16 + 4 * g)); ws = MFMA16(wa, sb[dk], ws); }
#pragma unroll
            for (int r = 0; r < 4; ++r) vn[it][r] = bf2f(UI[(16 * it + 4 * g + r) * 136 + 16 * w + c]) - ws[r]; }
        bf16x8 vb[2]; vb[0] = cvt8(vn[0], vn[1]); vb[1] = cvt8(vn[2], vn[3]);
        f32x4 O[4];
#pragma unroll
        for (int it = 0; it < 4; ++it) { O[it] = (f32x4){0.f, 0.f, 0.f, 0.f};
#pragma unroll
            for (int dk = 0; dk < 4; ++dk) { const bf16x8 qa = cat4(*(const LAS s16x4*)(QG + (16 * it + c) * 136 + 32 * dk + 4 * g), *(const LAS s16x4*)(QG + (16 * it + c) * 136 + 32 * dk + 16 + 4 * g)); O[it] = MFMA16(qa, sb[dk], O[it]); }
#pragma unroll
            for (int sk = 0; sk < 2; ++sk) { const bf16x8 aa = cat4(*(const LAS s16x4*)(AI + (16 * it + c) * 72 + 32 * sk + 4 * g), *(const LAS s16x4*)(AI + (16 * it + c) * 72 + 32 * sk + 16 + 4 * g)); O[it] = MFMA16(aa, vb[sk], O[it]); } }
#pragma unroll
        for (int dt = 0; dt < 8; ++dt) { S[dt] *= egl;
#pragma unroll
            for (int sk = 0; sk < 2; ++sk) { const LAS unsigned char* p = (const LAS unsigned char*)(KD + (32 * sk + 4 * g + (c >> 2)) * 136 + 16 * dt + 4 * (c & 3)); const bf16x8 ka = cat4(tr16(p), tr16(p + 16 * 136 * 2)); S[dt] = MFMA16(ka, vb[sk], S[dt]); } }
#pragma unroll
        for (int it = 0; it < 4; ++it)
#pragma unroll
            for (int r = 0; r < 4; ++r) { float s2 = O[it][r] * O[it][r];
#pragma unroll
                for (int x = 1; x < 16; x <<= 1) s2 += __shfl_xor(s2, x);
                if (c == 0) ST[(16 * it + 4 * g + r) * 8 + w] = s2; }
        *(LAS v4u*)(ZI + rr * 136 + 16 * sub) = rz[0]; *(LAS v4u*)(ZI + rr * 136 + 16 * sub + 8) = rz[1];
        __syncthreads();
        if (tid < 64) { float s2 = 0.f;
#pragma unroll
            for (int x = 0; x < 8; ++x) s2 += ST[tid * 8 + x];
            MR[tid] = rsqrtf(s2 * (1.f / 128.f) + EPS); }
        __syncthreads();
#pragma unroll
        for (int it = 0; it < 4; ++it)
#pragma unroll
            for (int r = 0; r < 4; ++r) { const int i = 16 * it + 4 * g + r; LAS bf16* zp = ZI + i * 136 + 16 * w + c; const float z = bf2f(*zp); *zp = (bf16)f2bf(O[it][r] * MR[i] * nw * silu(z)); }
        __syncthreads();
        { bf16* yp = (bf16*)(A.ws + WS_YC) + (row0 + 64 * n + rr) * GDN_VW + h * 128 + 16 * sub;
          *(GAS v4u*)yp = *(const LAS v4u*)(ZI + rr * 136 + 16 * sub); *(GAS v4u*)(yp + 8) = *(const LAS v4u*)(ZI + rr * 136 + 16 * sub + 8); }
    }
#undef GS_LOAD
    { float* sp = A.out + O_GDNP + ((size_t)(b * 32 + h) * 128) * 128;
#pragma unroll
      for (int dt = 0; dt < 8; ++dt)
#pragma unroll
          for (int r = 0; r < 4; ++r) sp[(size_t)(16 * dt + 4 * g + r) * 128 + 16 * w + c] = S[dt][r]; }
    __syncthreads();
}
DI void gdn_sample_unit(const Args& A, Frame& F, int b, int h) {
    __syncthreads();
    LAS float* KK = (LAS float*)(F.lds + RING_OFF);
    LAS float* QQ = KK + 1024;
    LAS float* VV = QQ + 1024;
    LAS float* UU = VV + 1024;
    LAS float* WT = UU + 1024;
    LAS float* QT = WT + 1024;
    LAS float* KT = QT + 1024;
    LAS float* VN = KT + 1024;
    LAS float* PT = VN + 1024;
    LAS float* DT = PT + 8192;
    LAS float* GCs = DT + 128;
    LAS float* ST = GCs + 16;
    const int tid = F.tid, lane = F.lane, w = F.wave, e = tid & 127, dq = tid >> 7;
    const size_t m0 = (size_t)TP + b * DSEQ;
    float s0[32];
    { const float* sp = A.in[I_SGDN] + ((size_t)(b * 32 + h) * 128 + 32 * dq) * 128 + e;
#pragma unroll
      for (int dd = 0; dd < 32; ++dd) s0[dd] = sp[(size_t)dd * 128]; }
    { const int row = tid >> 6, cc = tid & 63;
      const bf16* kp = (const bf16*)(A.ws + WS_KN) + (m0 + row) * 2048 + (h >> 1) * 128; const bf16* qp = (const bf16*)(A.ws + WS_QN) + (m0 + row) * 2048 + (h >> 1) * 128; const bf16* vp = (const bf16*)(A.ws + WS_VV) + (m0 + row) * 4096 + h * 128;
      KK[row * 128 + cc] = bf2f(kp[cc]); KK[row * 128 + 64 + cc] = bf2f(kp[64 + cc]); QQ[row * 128 + cc] = bf2f(qp[cc]) * 0.08838834764831845f; QQ[row * 128 + 64 + cc] = bf2f(qp[64 + cc]) * 0.08838834764831845f;
      VV[row * 128 + cc] = bf2f(vp[cc]); VV[row * 128 + 64 + cc] = bf2f(vp[64 + cc]); }
    if (tid == 0) { float acc = 0.f;
        for (int i = 0; i < 8; ++i) { acc += ((const float*)(A.ws + WS_GG))[(m0 + i) * 32 + h]; GCs[i] = acc; GCs[8 + i] = ((const float*)(A.ws + WS_GB))[(m0 + i) * 32 + h]; } }
    __syncthreads();
    if (tid < 128) { const int which = tid >> 6, cc = (tid >> 3) & 7, s = tid & 7; const LAS float* X = which ? QQ : KK; float d = 0.f;
        for (int i = 0; i < 128; ++i) d += X[cc * 128 + i] * KK[s * 128 + i];
        DT[which * 64 + cc * 8 + s] = d; }
    __syncthreads();
    const float gl = GCs[7];
    if (tid < 256) { const int col = tid; float x[8];
#pragma unroll
        for (int r = 0; r < 8; ++r) { const float bt = GCs[8 + r]; float acc = col < 128 ? bt * VV[r * 128 + col] : bt * __expf(GCs[r]) * KK[r * 128 + col - 128];
#pragma unroll
            for (int s = 0; s < 8; ++s) if (s < r) acc -= bt * DT[r * 8 + s] * __expf(GCs[r] - GCs[s]) * x[s];
            x[r] = acc; }
        if (col < 128) {
#pragma unroll
            for (int r = 0; r < 8; ++r) UU[r * 128 + col] = x[r]; }
        else {
#pragma unroll
            for (int r = 0; r < 8; ++r) WT[(col - 128) * 8 + r] = x[r]; } }
    else { const int d = tid - 256; if (d < 128) {
#pragma unroll
            for (int r = 0; r < 8; ++r) { QT[d * 8 + r] = QQ[r * 128 + d] * __expf(GCs[r]); KT[d * 8 + r] = KK[r * 128 + d] * __expf(gl - GCs[r]); } } }
    __syncthreads();
    { float pw[8], pq[8];
#pragma unroll
      for (int i = 0; i < 8; ++i) { pw[i] = 0.f; pq[i] = 0.f; }
#pragma unroll
      for (int dd = 0; dd < 32; ++dd) { const int d = 32 * dq + dd; const f32x4 wa = *(const LAS f32x4*)(WT + d * 8), wb = *(const LAS f32x4*)(WT + d * 8 + 4), qa = *(const LAS f32x4*)(QT + d * 8), qb = *(const LAS f32x4*)(QT + d * 8 + 4); const float s = s0[dd];
          pw[0] += wa.x * s; pw[1] += wa.y * s; pw[2] += wa.z * s; pw[3] += wa.w * s; pw[4] += wb.x * s; pw[5] += wb.y * s; pw[6] += wb.z * s; pw[7] += wb.w * s;
          pq[0] += qa.x * s; pq[1] += qa.y * s; pq[2] += qa.z * s; pq[3] += qa.w * s; pq[4] += qb.x * s; pq[5] += qb.y * s; pq[6] += qb.z * s; pq[7] += qb.w * s; }
#pragma unroll
      for (int i = 0; i < 8; ++i) { PT[(dq * 16 + i) * 128 + e] = pw[i]; PT[(dq * 16 + 8 + i) * 128 + e] = pq[i]; } }
    __syncthreads();
#pragma unroll
    for (int ii = 0; ii < 2; ++ii) { const int cc = 2 * dq + ii; VN[cc * 128 + e] = UU[cc * 128 + e] - (PT[cc * 128 + e] + PT[(16 + cc) * 128 + e] + PT[(32 + cc) * 128 + e] + PT[(48 + cc) * 128 + e]); }
    __syncthreads();
    float vn[8];
#pragma unroll
    for (int s = 0; s < 8; ++s) vn[s] = VN[s * 128 + e];
    float o[2];
#pragma unroll
    for (int ii = 0; ii < 2; ++ii) { const int cc = 2 * dq + ii; float x = PT[(8 + cc) * 128 + e] + PT[(24 + cc) * 128 + e] + PT[(40 + cc) * 128 + e] + PT[(56 + cc) * 128 + e];
#pragma unroll
        for (int s = 0; s < 8; ++s) if (s <= cc) x += DT[64 + cc * 8 + s] * __expf(GCs[cc] - GCs[s]) * vn[s];
        o[ii] = x; const float s2 = wave_sum(x * x); if (lane == 0) ST[cc * 2 + (w & 1)] = s2; }
    { const float egl = __expf(gl); float* sp = A.out + O_GDNS + ((size_t)(b * 32 + h) * 128 + 32 * dq) * 128 + e;
#pragma unroll
      for (int dd = 0; dd < 32; ++dd) { const int d = 32 * dq + dd; const f32x4 ka = *(const LAS f32x4*)(KT + d * 8), kb = *(const LAS f32x4*)(KT + d * 8 + 4);
          float sf = s0[dd] * egl; sf += ka.x * vn[0]; sf += ka.y * vn[1]; sf += ka.z * vn[2]; sf += ka.w * vn[3]; sf += kb.x * vn[4]; sf += kb.y * vn[5]; sf += kb.z * vn[6]; sf += kb.w * vn[7];
          sp[(size_t)dd * 128] = sf; } }
    __syncthreads();
    const float nw = A.in[I_GDNNW][e];
#pragma unroll
    for (int ii = 0; ii < 2; ++ii) { const int cc = 2 * dq + ii; const float rs = rsqrtf((ST[cc * 2] + ST[cc * 2 + 1]) * (1.f / 128.f) + EPS);
        const float z = bf2f(((const bf16*)(A.ws + WS_PROJ))[(m0 + cc) * ODD_INP + C_Z + h * 128 + e]);
        ((bf16*)(A.ws + WS_YC))[(m0 + cc) * GDN_VW + h * 128 + e] = (bf16)f2bf(o[ii] * rs * nw * silu(z)); }
    __syncthreads();
}
DI void ph_gdn_scan(const Args& A, Frame& F) {
    const int NP = NB * 32;
    if (F.bx < NP) { gdn_scan_unit(A, F, F.bx >> 5, F.bx & 31); return; }
    for (int u = F.bx - NP; u < DB * 32; u += F.G - NP) gdn_sample_unit(A, F, u >> 5, u & 31);
}
template <class Epi> DI void run_gemm(Frame& F, const bf16* Amat, const bf16* Bt, int M, int N, int K, const Epi& E, int coff = 0) {
    pg8::Gemm g{Amat, Bt, M, N, K}; pg8::StaticOrder S; S.init(M, N, F.G, (F.bx + F.G - coff) % F.G);
    pg8::gemm_phase<Epi, pg8::StaticOrder, true, true>(F.lds + RING_OFF, g, S, E);
}
constexpr int NPH = 25;
__global__ void __launch_bounds__(NTHR, 2) mk_fwd(Args args) {
    extern __shared__ __attribute__((aligned(16))) unsigned char lds[];
    Frame F;
    F.lds = (LAS unsigned char*)lds; F.MISC = (volatile LAS unsigned*)(F.lds + MISC_OFF);
    F.tid = threadIdx.x; F.lane = F.tid & 63; F.wave = __builtin_amdgcn_readfirstlane(F.tid >> 6); F.G = gridDim.x; F.bx = blockIdx.x;
    F.ctl = (gu32*)(args.ws + WS_CTL);
    for (int u = F.tid; u < (LDS_BYTES - LDSCTL_OFF) / 4; u += NTHR) ((LAS unsigned*)(F.lds + LDSCTL_OFF))[u] = 0u;
    __syncthreads();
    const int lo = args.ph_lo, hi = args.ph_hi;
    XcdBarrier bar; bar.bar = (unsigned*)(F.ctl + CW_BAR); bar.x = 0; bar.st = nullptr;
    if (hi - lo > 1) bar = xcd_barrier_post((unsigned*)(F.ctl + CW_BAR), F.MISC + 8);
#define IN(k) (lo <= (k) && (k) < hi)
#define SEAM(k) do { if (IN(k) && IN((k) + 1)) xcd_barrier(bar); } while (0)
    unsigned char* ws = args.ws; float* h = args.out + O_Y;
    bf16* U = (bf16*)(ws + WS_U); bf16* PJ = (bf16*)(ws + WS_PROJ); bf16* YC = (bf16*)(ws + WS_YC); bf16* QM = (bf16*)(ws + WS_QM); bf16* OM = (bf16*)(ws + WS_OM);

    if (IN(0)) ph_prologue(args, F);
    SEAM(0);
    if (IN(1)) {
        run_gemm(F, U, (const bf16*)(ws + WS_WINE), MT, EVEN_IN, D, pg8::EpiBf16<0>{PJ, EVEN_IN});
        run_gemm(F, (const bf16*)(ws + WS_MEMN), (const bf16*)(ws + WS_WL + WL_KV), NB * MEMT, 1024, D, pg8::EpiF32{nullptr, (float*)(ws + WS_KVRAW), 1024}, 192);
        run_gemm(F, (const bf16*)(ws + WS_MEMN) + (size_t)NB * MEMT * D, (const bf16*)(ws + WS_WL + WL_SZ + WL_KV), NB * MEMT, 1024, D, pg8::EpiF32{nullptr, (float*)(ws + WS_KVRAW) + (size_t)NB * MEMT * 1024, 1024}, 208);
    }
    SEAM(1);
    if (IN(2)) ph_post_even(args, F);
    SEAM(2);
    if (IN(3)) ph_mix_even(args, F);
    SEAM(3);
    if (IN(4)) run_gemm(F, YC, (const bf16*)(ws + WS_WOUTE), MT, D, EVEN_OUT, pg8::EpiF32{h, h, D});
    SEAM(4);
#define LAYER_TAIL(li, pb) do { unsigned char* wl = ws + WS_WL + (li) * WL_SZ; \
        if (IN(pb)) ph_rmsnorm(args, F, args.in[I_NMEM] + (li) * D); \
        SEAM(pb); \
        if (IN((pb) + 1)) run_gemm(F, U, (const bf16*)(wl + WL_Q), MT, MEM_W, D, pg8::EpiBf16<0>{QM, MEM_W}); \
        SEAM((pb) + 1); \
        if (IN((pb) + 2)) ph_mem_attn(args, F, (li)); \
        SEAM((pb) + 2); \
        if (IN((pb) + 3)) run_gemm(F, OM, (const bf16*)(wl + WL_O), MT, D, MEM_W, pg8::EpiF32{h, h, D}); \
        SEAM((pb) + 3); \
        if (IN((pb) + 4)) ph_rmsnorm(args, F, args.in[I_NFFN] + (li) * D); \
        SEAM((pb) + 4); \
        if (IN((pb) + 5)) run_gemm(F, U, (const bf16*)(wl + WL_1), MT, DFF, D, pg8::EpiBf16<2>{PJ, DFF}); \
        SEAM((pb) + 5); \
        if (IN((pb) + 6)) run_gemm(F, PJ, (const bf16*)(wl + WL_2), MT, D, DFF, pg8::EpiF32{h, h, D}); \
        SEAM((pb) + 6); } while (0)
    LAYER_TAIL(0, 5);
    if (IN(12)) ph_rmsnorm(args, F, args.in[I_NMIX] + D);
    SEAM(12);
    if (IN(13)) run_gemm(F, U, (const bf16*)(ws + WS_WINO), MT, ODD_INP, D, pg8::EpiBf16<0>{PJ, ODD_INP});
    SEAM(13);
    if (IN(14)) ph_gdn_pre(args, F);
    SEAM(14);
    if (IN(15)) ph_gdn_prep(args, F);
    SEAM(15);
    if (IN(16)) ph_gdn_scan(args, F);
    SEAM(16);
    if (IN(17)) run_gemm(F, YC, (const bf16*)(ws + WS_WOUTO), MT, D, GDN_VW, pg8::EpiF32{h, h, D});
    SEAM(17);
    LAYER_TAIL(1, 18);
#undef LAYER_TAIL
#undef IN
#undef SEAM
}
#ifndef MK_N_LAUNCHES
#define MK_N_LAUNCHES NPH
#endif
extern "C" void kernel_launch(void* const* d_in, const int* in_sizes, int n_in, void* d_out, int out_size, void* d_ws, size_t ws_size, hipStream_t stream) {
    static int grid = 0;
    if (grid == 0) {
        if (n_in != N_IN || (size_t)out_size != O_END || ws_size < WS_END) { fprintf(stderr, "kernel_launch: unexpected sizes (n_in %d, out %d, ws %zu); nothing launched\n", n_in, out_size, ws_size); grid = -1; return; }
        int dev = 0, cus = 0, per_cu = 0;
        if (hipGetDevice(&dev) != hipSuccess || hipDeviceGetAttribute(&cus, hipDeviceAttributeMultiprocessorCount, dev) != hipSuccess) { grid = -1; return; }
        if (hipFuncSetAttribute((const void*)mk_fwd, hipFuncAttributeMaxDynamicSharedMemorySize, LDS_BYTES) != hipSuccess) { fprintf(stderr, "kernel_launch: hipFuncSetAttribute failed\n"); grid = -1; return; }
        if (hipOccupancyMaxActiveBlocksPerMultiprocessor(&per_cu, (const void*)mk_fwd, NTHR, LDS_BYTES) != hipSuccess || per_cu < 1) fprintf(stderr, "kernel_launch: occupancy query reports %d\n", per_cu);
        (void)hipGetLastError();
        grid = cus;
    }
    if (grid < 0) return;
    if (hipMemsetAsync((char*)d_ws + WS_CTL, 0, CTL_ZERO_BYTES, stream) != hipSuccess) return;
    Args a{};
    for (int i = 0; i < N_IN; ++i) a.in[i] = (const float*)d_in[i];
    a.out = (float*)d_out; a.ws = (unsigned char*)d_ws;
    for (int li = 0; li < MK_N_LAUNCHES; ++li) {
        a.ph_lo = (MK_N_LAUNCHES == NPH) ? li : 0; a.ph_hi = (MK_N_LAUNCHES == NPH) ? li + 1 : NPH;
        hipLaunchKernelGGL(mk_fwd, dim3(grid), dim3(NTHR), LDS_BYTES, stream, a);
        if (hipPeekAtLastError() != hipSuccess) { fprintf(stderr, "kernel_launch: launch %d failed\n", li); break; }
    }
}
```
